# Optimizing an MI355X kernel written in HIP

```python
import jax, jax.numpy as jnp
from jax import lax
import numpy as np


D_MODEL = 1024
BATCH = 8
SEQ = 4096
DEPTH = 2

CTX_LEN = 256
GRID_W = 64
HEAD_DIM = 64
NA_HEADS = 6
NA_WIN_H = 8
NA_WIN_W = 16
NA_QBLK_W = 16
NA_KBLK_W = NA_QBLK_W + NA_WIN_W
SW_HEADS = 6
SW_KV_HEADS = 2
SW_WINDOW = 128
SW_BLOCK = 128
CONV_DIM = 256
CONV_WIDTH = 31
D_FF = 2816
ROPE_BASE = 10000.0
EPS = 1e-6
NEG_INF = -1e30
N_BRANCH = 3
N_MOD = 9

A_DIM = NA_HEADS * HEAD_DIM
B_Q_DIM = SW_HEADS * HEAD_DIM
B_KV_DIM = SW_KV_HEADS * HEAD_DIM
IN_DIM = 3 * A_DIM + B_Q_DIM + 2 * B_KV_DIM + 2 * CONV_DIM + N_BRANCH * D_MODEL
SPLIT_POINTS = (A_DIM, 2 * A_DIM, 3 * A_DIM, 3 * A_DIM + B_Q_DIM,
                3 * A_DIM + B_Q_DIM + B_KV_DIM, 3 * A_DIM + B_Q_DIM + 2 * B_KV_DIM,
                3 * A_DIM + B_Q_DIM + 2 * B_KV_DIM + 2 * CONV_DIM)

kernel_name = 'hybrid_natten_swa_conformer_prefix_dit_block'


def rms_norm(x, g):
    xf = x.astype(jnp.float32)
    y = xf * lax.rsqrt(jnp.mean(xf * xf, axis=-1, keepdims=True) + EPS)
    return (y * g.astype(jnp.float32)).astype(x.dtype)


def layer_norm(x, g, b):
    xf = x.astype(jnp.float32)
    mu = jnp.mean(xf, axis=-1, keepdims=True)
    var = jnp.mean(jnp.square(xf - mu), axis=-1, keepdims=True)
    y = (xf - mu) * lax.rsqrt(var + EPS) * g.astype(jnp.float32) + b.astype(jnp.float32)
    return y.astype(x.dtype)


def modulate(h, shift, scale):
    return h * (1 + scale) + shift


def swiglu(h, w_gu, w_down):
    a, b = jnp.split(h @ w_gu, 2, axis=-1)
    return (jax.nn.silu(a) * b) @ w_down


def axial_rope_tables(n_tokens):
    t = jnp.arange(n_tokens, dtype=jnp.int32)
    row = (t // GRID_W).astype(jnp.float32)
    col = (t % GRID_W).astype(jnp.float32)
    n_freq = HEAD_DIM // 4
    inv_freq = ROPE_BASE ** (-jnp.arange(n_freq, dtype=jnp.float32) / n_freq)
    ang = jnp.concatenate([row[:, None] * inv_freq, col[:, None] * inv_freq], axis=-1)
    return jnp.cos(ang), jnp.sin(ang)


def apply_axial_rope(x, cos, sin):
    half = HEAD_DIM // 2
    xf = x.astype(jnp.float32)
    x1, x2 = xf[..., :half], xf[..., half:]
    cs, sn = cos[None, :, None, :], sin[None, :, None, :]
    return jnp.concatenate([x1 * cs - x2 * sn, x1 * sn + x2 * cs], axis=-1).astype(x.dtype)


def split_combined(z):
    bsz, n, _ = z.shape
    qa, ka, va, qb, kb, vb, u, gates = jnp.split(z, SPLIT_POINTS, axis=-1)
    heads = lambda t, h: t.reshape(bsz, n, h, HEAD_DIM)
    return (heads(qa, NA_HEADS), heads(ka, NA_HEADS), heads(va, NA_HEADS),
            heads(qb, SW_HEADS), heads(kb, SW_KV_HEADS), heads(vb, SW_KV_HEADS), u, gates)


def neighborhood_attention(q, k, v, k_ctx, v_ctx, rpb, rows):
    bsz, n, h, d = q.shape
    n_ctx = k_ctx.shape[1]
    kh = min(NA_WIN_H, rows)
    ncb = GRID_W // NA_QBLK_W
    scale = d ** -0.5
    r = jnp.arange(rows)
    key_rows = jnp.clip(r - kh // 2, 0, rows - kh)[:, None] + jnp.arange(kh)[None]
    j = jnp.arange(ncb)
    blk_c0 = jnp.clip(j * NA_QBLK_W - NA_WIN_W // 2, 0, GRID_W - NA_KBLK_W)
    key_cols = blk_c0[:, None] + jnp.arange(NA_KBLK_W)[None]
    qg = q.reshape(bsz, rows, ncb, NA_QBLK_W, h, d)
    kg = k.reshape(bsz, rows, GRID_W, h, d)
    vg = v.reshape(bsz, rows, GRID_W, h, d)
    idx_r = key_rows[:, None, :, None]
    idx_c = key_cols[None, :, None, :]
    kb = kg[:, idx_r, idx_c]
    vb = vg[:, idx_r, idx_c]
    s_loc = jnp.einsum('brjqhd,brjyxhd->bhrjqyx', qg, kb, preferred_element_type=jnp.float32) * scale
    qcol = j[:, None] * NA_QBLK_W + jnp.arange(NA_QBLK_W)[None]
    win_c0 = jnp.clip(qcol - NA_WIN_W // 2, 0, GRID_W - NA_WIN_W)[..., None]
    kc = key_cols[:, None, :]
    in_win = (kc >= win_c0) & (kc < win_c0 + NA_WIN_W)
    dyi = key_rows - r[:, None] + (NA_WIN_H - 1)
    dxi = jnp.clip(kc - qcol[..., None] + (NA_WIN_W - 1), 0, 2 * NA_WIN_W - 2)
    bias = rpb[:, dyi[:, None, None, :, None], dxi[None, :, :, None, :]]
    s_loc = jnp.where(in_win[None, None, None, :, :, None, :], s_loc + bias.astype(jnp.float32)[None], NEG_INF)
    s_ctx = jnp.einsum('bshd,bchd->bhsc', q, k_ctx, preferred_element_type=jnp.float32) * scale
    s_ctx = s_ctx.reshape(bsz, h, rows, ncb, NA_QBLK_W, n_ctx)
    n_loc = kh * NA_KBLK_W
    p = jax.nn.softmax(jnp.concatenate([s_loc.reshape(bsz, h, rows, ncb, NA_QBLK_W, n_loc), s_ctx], axis=-1), axis=-1)
    p = p.astype(v.dtype)
    p_loc = p[..., :n_loc].reshape(bsz, h, rows, ncb, NA_QBLK_W, kh, NA_KBLK_W)
    o = (jnp.einsum('bhrjqyx,brjyxhd->brjqhd', p_loc, vb)
         + jnp.einsum('bhrjqc,bchd->brjqhd', p[..., n_loc:], v_ctx))
    return o.reshape(bsz, n, h * d)


def window_attention(q, k, v, k_ctx, v_ctx, sink):
    bsz, n, h, d = q.shape
    hkv = k.shape[2]
    g = h // hkv
    nb = n // SW_BLOCK
    scale = d ** -0.5
    pad = ((0, 0), (SW_BLOCK, SW_BLOCK), (0, 0), (0, 0))
    kp, vp = jnp.pad(k, pad), jnp.pad(v, pad)
    blk_idx = jnp.arange(nb)[:, None] * SW_BLOCK + jnp.arange(3 * SW_BLOCK)[None]
    kb, vb = kp[:, blk_idx], vp[:, blk_idx]
    qb = q.reshape(bsz, nb, SW_BLOCK, hkv, g, d)
    s_loc = jnp.einsum('bnqkgd,bnckd->bkgnqc', qb, kb, preferred_element_type=jnp.float32) * scale
    qpos = jnp.arange(n).reshape(nb, SW_BLOCK)
    kpos = blk_idx - SW_BLOCK
    valid = (jnp.abs(qpos[:, :, None] - kpos[:, None, :]) <= SW_WINDOW) & (kpos >= 0)[:, None, :] & (kpos < n)[:, None, :]
    s_loc = jnp.where(valid[None, None, None], s_loc, NEG_INF)
    s_ctx = jnp.einsum('bnqkgd,bmkd->bkgnqm', qb, k_ctx, preferred_element_type=jnp.float32) * scale
    s_sink = jnp.broadcast_to(sink.astype(jnp.float32).reshape(1, hkv, g, 1, 1, 1), s_loc.shape[:-1] + (1,))
    p = jax.nn.softmax(jnp.concatenate([s_loc, s_ctx, s_sink], axis=-1), axis=-1).astype(v.dtype)
    n_loc = 3 * SW_BLOCK
    n_ctx = k_ctx.shape[1]
    o = (jnp.einsum('bkgnqc,bnckd->bnqkgd', p[..., :n_loc], vb)
         + jnp.einsum('bkgnqm,bmkd->bnqkgd', p[..., n_loc:n_loc + n_ctx], v_ctx))
    return o.reshape(bsz, n, h * d)


def context_attention(q, k, v, sink):
    bsz, n_ctx, h, d = q.shape
    hkv = k.shape[2]
    g = h // hkv
    qg = q.reshape(bsz, n_ctx, hkv, g, d)
    s = jnp.einsum('bqkgd,bckd->bkgqc', qg, k, preferred_element_type=jnp.float32) * d ** -0.5
    if sink is None:
        p = jax.nn.softmax(s, axis=-1)
    else:
        s_sink = jnp.broadcast_to(sink.astype(jnp.float32).reshape(1, hkv, g, 1, 1), s.shape[:-1] + (1,))
        p = jax.nn.softmax(jnp.concatenate([s, s_sink], axis=-1), axis=-1)[..., :n_ctx]
    o = jnp.einsum('bkgqc,bckd->bqkgd', p.astype(v.dtype), v)
    return o.reshape(bsz, n_ctx, h * d)


def conformer_conv(u, dw_w, dw_b, ln_g, ln_b):
    a, gt = jnp.split(u, 2, axis=-1)
    h = a * jax.nn.sigmoid(gt)
    h = lax.conv_general_dilated(h, dw_w.astype(h.dtype)[:, None, :], window_strides=(1,),
                                 padding=((CONV_WIDTH // 2, CONV_WIDTH // 2),),
                                 dimension_numbers=('NWC', 'WIO', 'NWC'),
                                 feature_group_count=CONV_DIM) + dw_b
    return jax.nn.silu(layer_norm(h, ln_g, ln_b))


def merge_branches(ya, yb, yc, gate_logits, b_gate, w_oa, w_ob, w_oc, w_o):
    ga, gb, gc = jnp.split(jax.nn.sigmoid(gate_logits + b_gate), N_BRANCH, axis=-1)
    return (ga * (ya @ w_oa) + gb * (yb @ w_ob) + gc * (yc @ w_oc)) @ w_o


def setup_inputs(seed: int = 0) -> dict:
    key = jax.random.key(seed)
    ks = jax.random.split(key, 32)
    f32 = jnp.float32
    D = D_MODEL
    nrm = lambda k, shape, fan_in: jax.random.normal(k, shape, f32) * fan_in ** -0.5
    small = lambda k, shape, s: jax.random.normal(k, shape, f32) * s
    return {
        'x': jax.random.normal(ks[0], (BATCH, SEQ, D), f32),
        'c': jax.random.normal(ks[1], (BATCH, D), f32),
        'ctx': jax.random.normal(ks[2], (BATCH, CTX_LEN, D), f32),
        'c_ctx': jax.random.normal(ks[3], (D,), f32),
        'w_ada': nrm(ks[4], (DEPTH, D, N_MOD * D), D),
        'b_ada': small(ks[5], (DEPTH, N_MOD * D), 0.02),
        'norm_g': 1.0 + small(ks[6], (DEPTH, 3, D), 0.05),
        'w_ffn1_gu': nrm(ks[7], (DEPTH, D, 2 * D_FF), D),
        'w_ffn1_down': nrm(ks[8], (DEPTH, D_FF, D), D_FF),
        'w_ffn2_gu': nrm(ks[9], (DEPTH, D, 2 * D_FF), D),
        'w_ffn2_down': nrm(ks[10], (DEPTH, D_FF, D), D_FF),
        'w_in': nrm(ks[11], (DEPTH, D, IN_DIM), D),
        'b_gate': small(ks[12], (DEPTH, N_BRANCH * D), 0.02),
        'na_rpb': small(ks[13], (DEPTH, NA_HEADS, 2 * NA_WIN_H - 1, 2 * NA_WIN_W - 1), 0.1),
        'sw_sink': small(ks[14], (DEPTH, SW_HEADS), 0.5),
        'conv_dw_w': nrm(ks[15], (DEPTH, CONV_WIDTH, CONV_DIM), CONV_WIDTH),
        'conv_dw_b': small(ks[16], (DEPTH, CONV_DIM), 0.02),
        'conv_ln_g': 1.0 + small(ks[17], (DEPTH, CONV_DIM), 0.05),
        'conv_ln_b': small(ks[18], (DEPTH, CONV_DIM), 0.02),
        'w_out_a': nrm(ks[19], (DEPTH, A_DIM, D), A_DIM),
        'w_out_b': nrm(ks[20], (DEPTH, B_Q_DIM, D), B_Q_DIM),
        'w_out_c': nrm(ks[21], (DEPTH, CONV_DIM, D), CONV_DIM),
        'w_out': nrm(ks[22], (DEPTH, D, D), D),
        'final_g': 1.0 + small(ks[23], (D,), 0.05),
    }


def reference(x, c, ctx, c_ctx, w_ada, b_ada, norm_g, w_ffn1_gu, w_ffn1_down, w_ffn2_gu, w_ffn2_down,
              w_in, b_gate, na_rpb, sw_sink, conv_dw_w, conv_dw_b, conv_ln_g, conv_ln_b,
              w_out_a, w_out_b, w_out_c, w_out, final_g):
    n_tok = x.shape[1]
    rows = n_tok // GRID_W
    cos, sin = axial_rope_tables(n_tok)
    h_ctx = ctx
    silu_c = jax.nn.silu(c)
    silu_cc = jax.nn.silu(c_ctx)
    for l in range(DEPTH):
        last = l == DEPTH - 1
        mx = jnp.split((silu_c @ w_ada[l] + b_ada[l])[:, None, :], N_MOD, axis=-1)
        mc = jnp.split((silu_cc @ w_ada[l] + b_ada[l])[None, None, :], N_MOD, axis=-1)
        x = x + 0.5 * mx[2] * swiglu(modulate(rms_norm(x, norm_g[l, 0]), mx[0], mx[1]), w_ffn1_gu[l], w_ffn1_down[l])
        h_ctx = h_ctx + 0.5 * mc[2] * swiglu(modulate(rms_norm(h_ctx, norm_g[l, 0]), mc[0], mc[1]), w_ffn1_gu[l], w_ffn1_down[l])
        zx = modulate(rms_norm(x, norm_g[l, 1]), mx[3], mx[4]) @ w_in[l]
        zc = modulate(rms_norm(h_ctx, norm_g[l, 1]), mc[3], mc[4]) @ w_in[l]
        qa, ka, va, qb, kb, vb, ux, gx = split_combined(zx)
        qa_c, ka_c, va_c, qb_c, kb_c, vb_c, uc, gc = split_combined(zc)
        qb = apply_axial_rope(qb, cos, sin)
        kb = apply_axial_rope(kb, cos, sin)
        ya = neighborhood_attention(qa, ka, va, ka_c, va_c, na_rpb[l], rows)
        yb = window_attention(qb, kb, vb, kb_c, vb_c, sw_sink[l])
        yc = conformer_conv(ux, conv_dw_w[l], conv_dw_b[l], conv_ln_g[l], conv_ln_b[l])
        x = x + mx[5] * merge_branches(ya, yb, yc, gx, b_gate[l], w_out_a[l], w_out_b[l], w_out_c[l], w_out[l])
        if not last:
            ya_c = context_attention(qa_c, ka_c, va_c, None)
            yb_c = context_attention(qb_c, kb_c, vb_c, sw_sink[l])
            yc_c = conformer_conv(uc, conv_dw_w[l], conv_dw_b[l], conv_ln_g[l], conv_ln_b[l])
            h_ctx = h_ctx + mc[5] * merge_branches(ya_c, yb_c, yc_c, gc, b_gate[l], w_out_a[l], w_out_b[l], w_out_c[l], w_out[l])
        x = x + 0.5 * mx[8] * swiglu(modulate(rms_norm(x, norm_g[l, 2]), mx[6], mx[7]), w_ffn2_gu[l], w_ffn2_down[l])
        if not last:
            h_ctx = h_ctx + 0.5 * mc[8] * swiglu(modulate(rms_norm(h_ctx, norm_g[l, 2]), mc[6], mc[7]), w_ffn2_gu[l], w_ffn2_down[l])
    return rms_norm(x, final_g)
```

```cpp
#include <hip/hip_runtime.h>
#include <hip/hip_cooperative_groups.h>
#include <cstdio>
#include <cstdint>
namespace cg = cooperative_groups;
namespace pg8 {
#define PG8_LAS __attribute__((address_space(3)))
typedef unsigned short bf16_t;
typedef short bf16x8 __attribute__((ext_vector_type(8)));
typedef float f32x4 __attribute__((ext_vector_type(4)));
typedef unsigned u32x4 __attribute__((ext_vector_type(4)));
constexpr int BM = 256, BK = 64, HALF = 128, HTB = HALF * BK * 2  , STAGE_BYTES = 8 * HTB, NXCD = 8, WGM = 8;

__host__ __device__ __forceinline__ int lds_byte(int r, int c) { const int st = (r >> 4) * 2 + (c >> 5), rr = r & 15, cc = c & 31, ob = rr * 64 + cc * 2; return st * 1024 + (ob ^ (((ob >> 9) & 1) << 5)); }
__host__ __device__ __forceinline__ void stage_rc(int b, int& R, int& C) { const int st = b / 1024, sb = b % 1024, swz = sb ^ (((sb >> 9) & 1) << 5); R = (st >> 1) * 16 + swz / 64; C = (st & 1) * 32 + (swz % 64) / 2; }
__host__ __device__ __forceinline__ int perm32(int rho) { const int n = rho >> 4, i = rho & 15; return 8 * (i >> 2) + 4 * n + (i & 3); }

struct Unit { int pm, pn; };
struct Gemm { const bf16_t* A; const bf16_t* Bt; int M, N, K; int Kx; };

struct StaticOrder {
    int nM, nN, nwg, G, c;
    __host__ __device__ void init(int M, int N, int G_, int c_) { nM = M / BM; nN = N / BM; nwg = nM * nN; G = G_; c = c_; }
    __host__ __device__ bool next(int i, Unit& u) const {
        const long L = (long)i * G + c; if (L >= nwg) return false;
        int wgid = (int)L; { const int q = nwg / NXCD, r = nwg % NXCD, xcd = wgid % NXCD, off = wgid / NXCD; wgid = (xcd < r ? xcd * (q + 1) : r * (q + 1) + (xcd - r) * q) + off; }
        const int nig = WGM * nN, gid = wgid / nig, fm = gid * WGM, gsz = (nM - fm) < WGM ? (nM - fm) : WGM;
        u.pm = fm + ((wgid % nig) % gsz); u.pn = (wgid % nig) / gsz; return true;
    }
    __device__ __forceinline__ void a_ready(const Unit&) const {}
    __device__ __forceinline__ void done(const Unit&) const {}
};

__device__ __forceinline__ unsigned cvt_pk_bf16(float lo, float hi) { unsigned r; asm volatile("v_cvt_pk_bf16_f32 %0, %1, %2" : "=v"(r) : "v"(lo), "v"(hi)); return r; }
__device__ __forceinline__ float sigm(float x) { return __builtin_amdgcn_rcpf(1.f + __expf(-x)); }
__device__ __forceinline__ u32x4 pack8(const f32x4& v0, const f32x4& v1) { u32x4 w; w.x = cvt_pk_bf16(v0[0], v0[1]); w.y = cvt_pk_bf16(v0[2], v0[3]); w.z = cvt_pk_bf16(v1[0], v1[1]); w.w = cvt_pk_bf16(v1[2], v1[3]); return w; }
__device__ __forceinline__ f32x4 bflo(unsigned a, unsigned b) { f32x4 r; r[0] = __builtin_bit_cast(float, a << 16); r[1] = __builtin_bit_cast(float, a & 0xffff0000u); r[2] = __builtin_bit_cast(float, b << 16); r[3] = __builtin_bit_cast(float, b & 0xffff0000u); return r; }

struct EpiSwiGLU {
    static constexpr bool PERM = true, AFTER_DRAIN = false;
    bf16_t* O; int ldc;
    __device__ __forceinline__ void operator()(const f32x4 (&acc)[2][2][4][2], const Unit& u, int wr, int wc, int fr, int fq) const {
        const int row0 = u.pm * BM + wr * 64 + fr, col0 = u.pn * HALF + wc * 32 + 8 * fq;
#pragma unroll
        for (int ai = 0; ai < 2; ++ai)
#pragma unroll
            for (int m = 0; m < 4; ++m) {
                f32x4 v[2];
#pragma unroll
                for (int n = 0; n < 2; ++n)
#pragma unroll
                    for (int j = 0; j < 4; ++j) { const float a = acc[ai][0][m][n][j], b = acc[ai][1][m][n][j]; v[n][j] = a * sigm(a) * b; }
                *(u32x4*)(O + (size_t)(row0 + ai * HALF + m * 16) * ldc + col0) = pack8(v[0], v[1]);
            }
    }
};

struct EpiResid {
    static constexpr bool PERM = true, AFTER_DRAIN = false;
    const void* srcL; const void* srcC; int src_f32; bf16_t* dstL; bf16_t* dstC; const float* gate; float coef;
    __device__ __forceinline__ void operator()(const f32x4 (&acc)[2][2][4][2], const Unit& u, int wr, int wc, int fr, int fq) const {
        const bool lat = u.pm < 128;
        const size_t tile0 = (size_t)(lat ? u.pm : u.pm - 128) * BM * 1024;
        const void* srcv = lat ? srcL : srcC;
        bf16_t* dst = (lat ? dstL : dstC) + tile0;
        const float* g = gate + (lat ? (u.pm >> 4) : 8) * 9216;
        const int rl = wr * 64 + fr, col0 = u.pn * BM + wc * 32 + 8 * fq;
        f32x4 gv[2][2];
#pragma unroll
        for (int bj = 0; bj < 2; ++bj)
#pragma unroll
            for (int n = 0; n < 2; ++n) gv[bj][n] = *(const f32x4*)(g + col0 + bj * HALF + 4 * n) * coef;
#pragma unroll
        for (int ai = 0; ai < 2; ++ai)
#pragma unroll
            for (int m = 0; m < 4; ++m)
#pragma unroll
                for (int bj = 0; bj < 2; ++bj) {
                    const size_t off = (size_t)(rl + ai * HALF + m * 16) * 1024 + col0 + bj * HALF;
                    f32x4 x0, x1;
                    if (src_f32) { const float* sp = (const float*)srcv + tile0 + off; x0 = *(const f32x4*)sp; x1 = *(const f32x4*)(sp + 4); }
                    else { const u32x4 w = *(const u32x4*)((const bf16_t*)srcv + tile0 + off); x0 = bflo(w.x, w.y); x1 = bflo(w.z, w.w); }
                    *(u32x4*)(dst + off) = pack8(x0 + gv[bj][0] * acc[ai][bj][m][0], x1 + gv[bj][1] * acc[ai][bj][m][1]);
                }
    }
};

struct EpiIn1 {
    static constexpr bool PERM = true, AFTER_DRAIN = false;
    bf16_t *QB, *KB, *QA, *KA, *HG; const float* rope; float qs;
    __device__ __forceinline__ void operator()(const f32x4 (&acc)[2][2][4][2], const Unit& u, int wr, int wc, int fr, int fq) const {
        const int row0 = u.pm * BM + wr * 64 + fr; const bool lat = u.pm < 128; const int pn = u.pn;
        if (pn < 2) {
            const int g8 = 4 * pn + wc; bf16_t* dst = g8 < 6 ? QB + g8 * 64 : KB + (g8 - 6) * 64; const int ld = g8 < 6 ? 384 : 128; const float sc = g8 < 6 ? qs : 1.f;
#pragma unroll
            for (int ai = 0; ai < 2; ++ai)
#pragma unroll
                for (int m = 0; m < 4; ++m) {
                    const int row = row0 + ai * HALF + m * 16;
                    f32x4 y1[2], y2[2];
                    if (lat) {
                        const int t = row & 4095, pos = fq < 2 ? (t >> 6) : (t & 63); const float* rp = rope + pos * 16 + 8 * (fq & 1);
#pragma unroll
                        for (int n = 0; n < 2; ++n) { const f32x4 c = *(const f32x4*)(rp + 4 * n), s = *(const f32x4*)(rp + 1024 + 4 * n);
                            const f32x4 x1 = acc[ai][0][m][n], x2 = acc[ai][1][m][n]; y1[n] = x1 * c - x2 * s; y2[n] = x1 * s + x2 * c; }
                    } else { y1[0] = acc[ai][0][m][0]; y1[1] = acc[ai][0][m][1]; y2[0] = acc[ai][1][m][0]; y2[1] = acc[ai][1][m][1]; }
                    bf16_t* rowp = dst + (size_t)row * ld + 8 * fq;
                    *(u32x4*)(rowp) = pack8(y1[0] * sc, y1[1] * sc); *(u32x4*)(rowp + 32) = pack8(y2[0] * sc, y2[1] * sc);
                }
        } else if (pn < 5) {
#pragma unroll
            for (int bj = 0; bj < 2; ++bj) {
                const int c = (pn - 2) * BM + bj * HALF + wc * 32 + 8 * fq; bf16_t* dst = c < 384 ? QA + c : KA + (c - 384); const float sc = c < 384 ? qs : 1.f;
#pragma unroll
                for (int ai = 0; ai < 2; ++ai)
#pragma unroll
                    for (int m = 0; m < 4; ++m) *(u32x4*)(dst + (size_t)(row0 + ai * HALF + m * 16) * 384) = pack8(acc[ai][bj][m][0] * sc, acc[ai][bj][m][1] * sc);
            }
        } else {
            const int col = (pn - 5) * HALF + wc * 32 + 8 * fq;
#pragma unroll
            for (int ai = 0; ai < 2; ++ai)
#pragma unroll
                for (int m = 0; m < 4; ++m) {
                    f32x4 v[2];
#pragma unroll
                    for (int n = 0; n < 2; ++n)
#pragma unroll
                        for (int j = 0; j < 4; ++j) v[n][j] = acc[ai][0][m][n][j] * sigm(acc[ai][1][m][n][j]);
                    *(u32x4*)(HG + (size_t)(row0 + ai * HALF + m * 16) * 256 + col) = pack8(v[0], v[1]);
                }
        }
    }
};

struct EpiBf16 {
    static constexpr bool PERM = true, AFTER_DRAIN = false;
    bf16_t* O; int ldc;
    __device__ __forceinline__ void operator()(const f32x4 (&acc)[2][2][4][2], const Unit& u, int wr, int wc, int fr, int fq) const {
        const int row0 = u.pm * BM + wr * 64 + fr, col0 = u.pn * BM + wc * 32 + 8 * fq;
#pragma unroll
        for (int ai = 0; ai < 2; ++ai)
#pragma unroll
            for (int m = 0; m < 4; ++m)
#pragma unroll
                for (int bj = 0; bj < 2; ++bj) *(u32x4*)(O + (size_t)(row0 + ai * HALF + m * 16) * ldc + col0 + bj * HALF) = pack8(acc[ai][bj][m][0], acc[ai][bj][m][1]);
    }
};

struct EpiF32 {
    static constexpr bool PERM = true, AFTER_DRAIN = false;
    float* O; int ldc;
    __device__ __forceinline__ void operator()(const f32x4 (&acc)[2][2][4][2], const Unit& u, int wr, int wc, int fr, int fq) const {
        const int row0 = u.pm * BM + wr * 64 + fr, col0 = u.pn * BM + wc * 32 + 8 * fq;
#pragma unroll
        for (int ai = 0; ai < 2; ++ai)
#pragma unroll
            for (int m = 0; m < 4; ++m)
#pragma unroll
                for (int bj = 0; bj < 2; ++bj) { float* o = O + (size_t)(row0 + ai * HALF + m * 16) * ldc + col0 + bj * HALF; *(f32x4*)o = acc[ai][bj][m][0]; *(f32x4*)(o + 4) = acc[ai][bj][m][1]; }
    }
};

struct EpiGate {
    static constexpr bool PERM = true, AFTER_DRAIN = false;
    bf16_t* P; bf16_t* T; const float* bg; int br;
    __device__ __forceinline__ void operator()(const f32x4 (&acc)[2][2][4][2], const Unit& u, int wr, int wc, int fr, int fq) const {
        const int row0 = u.pm * BM + wr * 64 + fr, col0 = u.pn * BM + wc * 32 + 8 * fq;
        f32x4 bv[2][2];
#pragma unroll
        for (int bj = 0; bj < 2; ++bj)
#pragma unroll
            for (int n = 0; n < 2; ++n) bv[bj][n] = *(const f32x4*)(bg + col0 + bj * HALF + 4 * n);
#pragma unroll
        for (int ai = 0; ai < 2; ++ai)
#pragma unroll
            for (int m = 0; m < 4; ++m)
#pragma unroll
                for (int bj = 0; bj < 2; ++bj) {
                    const size_t off = (size_t)(row0 + ai * HALF + m * 16) * 1024 + col0 + bj * HALF;
                    const u32x4 pw = *(const u32x4*)(P + off);
                    const f32x4 p0 = bflo(pw.x, pw.y), p1 = bflo(pw.z, pw.w);
                    f32x4 t0, t1;
#pragma unroll
                    for (int j = 0; j < 4; ++j) { t0[j] = sigm(acc[ai][bj][m][0][j] + bv[bj][0][j]) * p0[j]; t1[j] = sigm(acc[ai][bj][m][1][j] + bv[bj][1][j]) * p1[j]; }
                    if (br != 0) { const u32x4 tw = *(const u32x4*)(T + off); t0 = t0 + bflo(tw.x, tw.y); t1 = t1 + bflo(tw.z, tw.w); }
                    *(u32x4*)((br == 2 ? P : T) + off) = pack8(t0, t1);
                }
    }
};

template <class Epi, class Sched, bool ALIGN_EPI = false, bool SP2 = false>
__device__ __forceinline__ void gemm_phase(PG8_LAS unsigned char* lds, const Gemm g, const Sched& S, const Epi& E) {
    int tid_l = threadIdx.x; asm volatile("" : "+v"(tid_l));
    const int tid = tid_l, wid = __builtin_amdgcn_readfirstlane(tid >> 6), lane = tid & 63, wr = wid >> 2, wc = wid & 3, fr = lane & 15, fq = lane >> 4;
    const int K = g.K, nt = (g.Kx ? g.Kx : K) / BK;
    unsigned voffA[2], voffB[2];
#pragma unroll
    for (int i = 0; i < 2; ++i) { int R, C; stage_rc(tid * 16 + i * 8192, R, C); const int Rb = Epi::PERM ? ((R & ~31) + perm32(R & 31)) : R;
        voffA[i] = (unsigned)(R * K + C) * 2u; voffB[i] = (unsigned)(Rb * K + C) * 2u; }
    const size_t kstep = (size_t)(BK * 2);
    const size_t hstep = (size_t)HALF * K * 2;
    const size_t tstep = 2 * hstep;
    const unsigned ldsw = (unsigned)wid * 1024u;
    const int aoff = lds_byte(wr * 64 + fr, fq * 8), boff = lds_byte(wc * 32 + fr, fq * 8);
#define PG8_SA(b, h) (((b) * 2 + (h)) * HTB)
#define PG8_SB(b, h) ((4 + (b) * 2 + (h)) * HTB)
#define PG8_STAGE(bufoff, gbase, voff) do { _Pragma("unroll") for (int _i = 0; _i < 2; ++_i) \
        __builtin_amdgcn_global_load_lds((const unsigned*)((const char*)(gbase) + (voff)[_i]), (PG8_LAS unsigned*)(lds + (bufoff) + ldsw + _i * 8192), 16, 0, 0); } while (0)
#define PG8_LDA(dst, b, h) do { _Pragma("unroll") for (int m = 0; m < 4; ++m) _Pragma("unroll") for (int k = 0; k < 2; ++k) dst[m][k] = *(const PG8_LAS bf16x8*)(lds + PG8_SA(b, h) + aoff + m * 2048 + k * 1024); } while (0)
#define PG8_LDB(dst, b, h) do { _Pragma("unroll") for (int n = 0; n < 2; ++n) _Pragma("unroll") for (int k = 0; k < 2; ++k) dst[n][k] = *(const PG8_LAS bf16x8*)(lds + PG8_SB(b, h) + boff + n * 2048 + k * 1024); } while (0)
#define PG8_MMA(ai, bj, At, Bt) do { __builtin_amdgcn_s_setprio(1); _Pragma("unroll") for (int m = 0; m < 4; ++m) _Pragma("unroll") for (int n = 0; n < 2; ++n) _Pragma("unroll") for (int k = 0; k < 2; ++k) \
        acc[ai][bj][m][n] = __builtin_amdgcn_mfma_f32_16x16x32_bf16(Bt[n][k], At[m][k], acc[ai][bj][m][n], 0, 0, 0); __builtin_amdgcn_s_setprio(0); } while (0)
#define PG8_WAIT_V(n) asm volatile("s_waitcnt vmcnt(" #n ")" ::: "memory")
#define PG8_WAIT_L(n) asm volatile("s_waitcnt lgkmcnt(" #n ")" ::: "memory")
#define PG8_BAR __builtin_amdgcn_s_barrier()
#define PG8_SCHED __builtin_amdgcn_sched_barrier(0)
    Unit cur, nxt; int ui = 0;
    if (!S.next(0, cur)) return;
    f32x4 acc[2][2][4][2];
#pragma unroll
    for (int a = 0; a < 2; ++a)
#pragma unroll
        for (int b = 0; b < 2; ++b)
#pragma unroll
            for (int m = 0; m < 4; ++m)
#pragma unroll
                for (int n = 0; n < 2; ++n) acc[a][b][m][n] = (f32x4){0.f, 0.f, 0.f, 0.f};
    bf16x8 At[4][2], B0[2][2], B1[2][2];
    const char* cA = (const char*)g.A + (size_t)cur.pm * tstep; const char* cB = (const char*)g.Bt + (size_t)cur.pn * tstep;
    S.a_ready(cur);
    if constexpr (SP2) {
        PG8_STAGE(PG8_SB(0, 0), cB, voffB); PG8_STAGE(PG8_SB(0, 1), cB + hstep, voffB); PG8_STAGE(PG8_SA(0, 0), cA, voffA); PG8_STAGE(PG8_SA(0, 1), cA + hstep, voffA);
        if (wr == 1) PG8_BAR;
        PG8_WAIT_V(2); PG8_BAR;
        PG8_STAGE(PG8_SB(1, 0), cB + kstep, voffB); PG8_STAGE(PG8_SA(1, 0), cA + kstep, voffA); PG8_STAGE(PG8_SB(1, 1), cB + hstep + kstep, voffB);
        PG8_WAIT_V(6); PG8_BAR;
    } else {
        PG8_STAGE(PG8_SB(0, 0), cB, voffB); PG8_STAGE(PG8_SA(0, 0), cA, voffA); PG8_STAGE(PG8_SB(0, 1), cB + hstep, voffB); PG8_STAGE(PG8_SA(0, 1), cA + hstep, voffA);
        if (wr == 1) PG8_BAR;
        PG8_WAIT_V(4); PG8_BAR;
        PG8_STAGE(PG8_SB(1, 0), cB + kstep, voffB); PG8_STAGE(PG8_SA(1, 0), cA + kstep, voffA); PG8_STAGE(PG8_SB(1, 1), cB + hstep + kstep, voffB);
        PG8_WAIT_V(6); PG8_BAR;
    }
    for (;;) {
        const bool has_next = S.next(ui + 1, nxt);
        const char* nA = has_next ? (const char*)g.A + (size_t)nxt.pm * tstep : cA; const char* nB = has_next ? (const char*)g.Bt + (size_t)nxt.pn * tstep : cB;
        for (int t = 0; t < nt; t += 2) {
            const bool last = (t == nt - 2);
            const char* a1 = cA + (size_t)(t + 1) * kstep;
            const char* a2 = last ? nA : cA + (size_t)(t + 2) * kstep; const char* b2 = last ? nB : cB + (size_t)(t + 2) * kstep;
            const char* a3 = a2 + kstep; const char* b3 = b2 + kstep;
            if (last && has_next) S.a_ready(nxt);
            if constexpr (SP2) {
            PG8_LDB(B0, 0, 0); PG8_LDB(B1, 0, 1); PG8_SCHED; PG8_LDA(At, 0, 0); PG8_STAGE(PG8_SA(1, 1), a1 + hstep, voffA);
            PG8_WAIT_V(8); PG8_WAIT_L(0); PG8_BAR; PG8_MMA(0, 0, At, B0); PG8_MMA(0, 1, At, B1); PG8_BAR; PG8_SCHED;
            PG8_LDA(At, 0, 1); PG8_STAGE(PG8_SB(0, 0), b2, voffB); PG8_STAGE(PG8_SB(0, 1), b2 + hstep, voffB); PG8_STAGE(PG8_SA(0, 0), a2, voffA);
            PG8_WAIT_V(8); PG8_WAIT_L(0); PG8_BAR; PG8_MMA(1, 0, At, B0); PG8_MMA(1, 1, At, B1); PG8_BAR; PG8_SCHED;
            PG8_LDB(B0, 1, 0); PG8_LDB(B1, 1, 1); PG8_SCHED; PG8_LDA(At, 1, 0); PG8_STAGE(PG8_SA(0, 1), a2 + hstep, voffA);
            PG8_WAIT_V(8); PG8_WAIT_L(0); PG8_BAR; PG8_MMA(0, 0, At, B0); PG8_MMA(0, 1, At, B1); PG8_BAR; PG8_SCHED;
            PG8_LDA(At, 1, 1); PG8_STAGE(PG8_SB(1, 0), b3, voffB); PG8_STAGE(PG8_SB(1, 1), b3 + hstep, voffB); PG8_STAGE(PG8_SA(1, 0), a3, voffA);
            PG8_WAIT_V(8); PG8_WAIT_L(0); PG8_BAR; PG8_MMA(1, 0, At, B0); PG8_MMA(1, 1, At, B1); PG8_BAR; PG8_SCHED;
            } else {
            PG8_LDB(B0, 0, 0); PG8_SCHED; PG8_LDA(At, 0, 0); PG8_STAGE(PG8_SA(1, 1), a1 + hstep, voffA);
            PG8_WAIT_L(8); PG8_BAR; PG8_WAIT_L(0); PG8_MMA(0, 0, At, B0); PG8_BAR; PG8_SCHED;
            PG8_LDB(B1, 0, 1); PG8_STAGE(PG8_SB(0, 0), b2, voffB);
            PG8_BAR; PG8_WAIT_L(0); PG8_MMA(0, 1, At, B1); PG8_BAR;
            PG8_LDA(At, 0, 1); PG8_STAGE(PG8_SA(0, 0), a2, voffA);
            PG8_BAR; PG8_WAIT_L(0); PG8_MMA(1, 0, At, B0); PG8_BAR; PG8_SCHED;
            PG8_STAGE(PG8_SB(0, 1), b2 + hstep, voffB);
            PG8_WAIT_V(6); PG8_BAR; PG8_MMA(1, 1, At, B1); PG8_BAR;
            PG8_LDB(B0, 1, 0); PG8_SCHED; PG8_LDA(At, 1, 0); PG8_STAGE(PG8_SA(0, 1), a2 + hstep, voffA);
            PG8_WAIT_L(8); PG8_BAR; PG8_WAIT_L(0); PG8_MMA(0, 0, At, B0); PG8_BAR; PG8_SCHED;
            PG8_LDB(B1, 1, 1); PG8_STAGE(PG8_SB(1, 0), b3, voffB);
            PG8_BAR; PG8_WAIT_L(0); PG8_MMA(0, 1, At, B1); PG8_BAR;
            PG8_LDA(At, 1, 1); PG8_STAGE(PG8_SA(1, 0), a3, voffA);
            PG8_BAR; PG8_WAIT_L(0); PG8_MMA(1, 0, At, B0); PG8_BAR; PG8_SCHED;
            PG8_STAGE(PG8_SB(1, 1), b3 + hstep, voffB);
            PG8_WAIT_V(6); PG8_BAR; PG8_MMA(1, 1, At, B1); PG8_BAR;
            }
        }
        if constexpr (ALIGN_EPI) { if (wr == 0) PG8_BAR; }
        if constexpr (!Epi::AFTER_DRAIN) { E(acc, cur, wr, wc, fr, fq); S.done(cur); }
        if (!has_next) break;
#pragma unroll
        for (int a = 0; a < 2; ++a)
#pragma unroll
            for (int b = 0; b < 2; ++b)
#pragma unroll
                for (int m = 0; m < 4; ++m)
#pragma unroll
                    for (int n = 0; n < 2; ++n) acc[a][b][m][n] = (f32x4){0.f, 0.f, 0.f, 0.f};
        cur = nxt; cA = nA; cB = nB; ++ui;
        if constexpr (ALIGN_EPI) { if (wr == 1) PG8_BAR; }
    }
    PG8_WAIT_V(0);
    if constexpr (!ALIGN_EPI) { if (wr == 0) PG8_BAR; }
    PG8_BAR;
    if constexpr (Epi::AFTER_DRAIN) { E.fused(acc, cur, wr, wc, fr, fq, lds, wid, lane); S.done(cur); }
#undef PG8_SA
#undef PG8_SB
#undef PG8_STAGE
#undef PG8_LDA
#undef PG8_LDB
#undef PG8_MMA
#undef PG8_WAIT_V
#undef PG8_WAIT_L
#undef PG8_BAR
#undef PG8_SCHED
}
}

#define LAS __attribute__((address_space(3)))
typedef unsigned short bf16;
typedef float f32x4 __attribute__((ext_vector_type(4)));
typedef short bf16x8 __attribute__((ext_vector_type(8)));
typedef unsigned u32x4 __attribute__((ext_vector_type(4)));
typedef unsigned u32x2 __attribute__((ext_vector_type(2)));

constexpr int DM = 1024, NB = 8, SEQ = 4096, MLAT = NB * SEQ, CTXL = 256, MCTX = NB * CTXL, MALL = MLAT + MCTX, DFF = 2816;
constexpr int NMODC = 9 * DM, IN_DIM = 5376;
constexpr float LOG2E = 1.4426950408889634f, SCL2 = 0.125f * LOG2E, NEGB = -1e30f, RMS_EPS = 1e-6f;
constexpr int NWAVES = 8, NTHR = 512;
constexpr int LDS_BYTES = 147456, LDS_ST = 147456 - 64;

constexpr size_t MiB = 1u << 20;
constexpr size_t WS_MOD = 0, WS_ROPE = 1 * MiB, WS_CTR = 1 * MiB + 65536, WS_BAR = 1 * MiB + 131072, WS_XC = 2 * MiB, WS_H = 10 * MiB, WS_R = 78 * MiB, WS_P = 282 * MiB, WS_W = 350 * MiB, WS_XB = 445 * MiB, WS_END = 509 * MiB;
constexpr size_t R_QB = 0, R_KB = R_QB + (size_t)MALL * 384 * 2, R_QA = R_KB + (size_t)MALL * 128 * 2, R_KA = R_QA + (size_t)MALL * 384 * 2, R_HG = R_KA + (size_t)MALL * 384 * 2,
                 R_VT = R_HG + (size_t)MALL * 256 * 2, R_YA = R_VT + (size_t)MALL * 512 * 2, R_YB = R_YA + (size_t)MALL * 384 * 2, R_YC = R_YB + (size_t)MALL * 384 * 2, R_END = R_YC + (size_t)MALL * 256 * 2;
static_assert(R_YA == (size_t)MALL * 1024 * 4 && R_END <= 204 * MiB && (size_t)MALL * DFF * 2 <= 204 * MiB, "region map");
constexpr size_t WO_GU1 = 0, WO_DN1 = 5767168, WO_GU2 = 8650752, WO_DN2 = 14417920, WO_IN = 17301504, WO_OA = 22806528, WO_OB = 23199744, WO_OC = 23592960, WO_WO = 23855104, WL_ELEMS = 24903680;
static_assert(WS_W + 2 * WL_ELEMS * 2 <= WS_XB && WS_XB + (size_t)MLAT * DM * 2 <= WS_END, "weights / residual map");

struct Args { const float* in[24]; float* out; unsigned char* ws; int ph_lo, ph_hi; };
typedef const __attribute__((address_space(4))) Args* KArgs;
__device__ __forceinline__ KArgs kargs() { KArgs p = (KArgs)__builtin_amdgcn_kernarg_segment_ptr(); asm volatile("" : "+s"(p)); return p; }

__device__ __forceinline__ float wave_sum(float v) {
#pragma unroll
    for (int o = 1; o < 64; o <<= 1) v += __shfl_xor(v, o);
    return v;
}
__device__ __forceinline__ unsigned pk2(float lo, float hi) { return pg8::cvt_pk_bf16(lo, hi); }
__device__ __forceinline__ float silu_f(float x) { return x * __builtin_amdgcn_rcpf(1.f + __expf(-x)); }
__device__ __forceinline__ float ex2(float x) { return __builtin_amdgcn_exp2f(x); }

__device__ __forceinline__ int gu_row(int n0) { const int h = n0 >= DFF, r = n0 - h * DFF; return 256 * (r >> 7) + 128 * h + (r & 127); }
__device__ __forceinline__ int in_row(int n0) {
    if (n0 < 768) return 512 + n0;
    if (n0 < 1152) return 1792 + (n0 - 768);
    if (n0 < 1664) { const int s = n0 - 1152, g8 = s >> 6, hf = (s >> 5) & 1; return 256 * (g8 >> 2) + 128 * hf + 32 * (g8 & 3); }
    if (n0 < 1792) return 1792 + 384 + (n0 - 1664);
    if (n0 < 2304) { const int s = n0 - 1792, hf = s >> 8, r = s & 255; return 1280 + 256 * (r >> 7) + 128 * hf + (r & 127); }
    return n0;
}
__device__ __forceinline__ void transpose_item(const float* W, int K, int N, bf16* WT, int k0, int n0, int drow0, LAS float* scr, int lane) {
#pragma unroll 8
    for (int i = 0; i < 32; ++i) { const int kk = 2 * i + (lane >> 5); scr[kk * 33 + (lane & 31)] = W[(size_t)(k0 + kk) * N + n0 + (lane & 31)]; }
    asm volatile("s_waitcnt lgkmcnt(0)" ::: "memory");
    const int c = lane & 7;
#pragma unroll
    for (int j = 0; j < 4; ++j) { const int n = (lane >> 3) + 8 * j; const LAS float* s = scr + (8 * c) * 33 + n;
        u32x4 o; o.x = pk2(s[0 * 33], s[1 * 33]); o.y = pk2(s[2 * 33], s[3 * 33]); o.z = pk2(s[4 * 33], s[5 * 33]); o.w = pk2(s[6 * 33], s[7 * 33]);
        *(u32x4*)(WT + (size_t)(drow0 + n) * K + k0 + 8 * c) = o; }
    asm volatile("s_waitcnt lgkmcnt(0)" ::: "memory");
}

__device__ __forceinline__ void prologue(KArgs pa, LAS unsigned char* lds, int tid, int lane, int wave) {
    const int G = gridDim.x, bx = blockIdx.x;
    float* modv = (float*)(pa->ws + WS_MOD);
    if (bx == 0) { float* rt = (float*)(pa->ws + WS_ROPE);
        if (tid < 36) __hip_atomic_store((unsigned*)(pa->ws + WS_CTR) + 64 * tid, 0u, __ATOMIC_RELAXED, __HIP_MEMORY_SCOPE_AGENT);
        for (int i = tid; i < 3456  ; i += NTHR) __hip_atomic_store((unsigned*)(pa->ws + WS_BAR) + i, 0u, __ATOMIC_RELAXED, __HIP_MEMORY_SCOPE_AGENT);
        for (int i = tid; i < 1024; i += NTHR) { const int pos = i >> 4, f = i & 15; const float inv = exp2f(-(float)f * (13.287712379549449f / 16.f)); const float ang = (float)pos * inv;
            rt[i] = cosf(ang); rt[1024 + i] = sinf(ang); } }
    if (bx < 288) {
        LAS float* sc = (LAS float*)lds; LAS float* part = (LAS float*)(lds + 36864);
        for (int i = tid; i < 9 * DM; i += NTHR) { const int row = i >> 10, k = i & 1023; const float v = row < 8 ? pa->in[1][row * DM + k] : pa->in[3][k]; sc[i] = silu_f(v); }
        __syncthreads();
        for (int unit = bx; unit < 288; unit += G) {
            const int l = unit / 144, cg64 = unit % 144, col = cg64 * 64 + lane;
            const float* w = pa->in[4] + (size_t)l * DM * NMODC + col;
            float acc[9];
#pragma unroll
            for (int r = 0; r < 9; ++r) acc[r] = 0.f;
            for (int k = wave * 128; k < wave * 128 + 128; k += 4) {
                const float w0 = w[(size_t)k * NMODC], w1 = w[(size_t)(k + 1) * NMODC], w2 = w[(size_t)(k + 2) * NMODC], w3 = w[(size_t)(k + 3) * NMODC];
#pragma unroll
                for (int r = 0; r < 9; ++r) { const f32x4 s = *(const LAS f32x4*)(sc + r * DM + k); acc[r] += s[0] * w0 + s[1] * w1 + s[2] * w2 + s[3] * w3; }
            }
#pragma unroll
            for (int r = 0; r < 9; ++r) part[(wave * 9 + r) * 64 + lane] = acc[r];
            __syncthreads();
            for (int i = tid; i < 576; i += NTHR) { const int r = i >> 6, cl = i & 63; float s = 0.f;
#pragma unroll
                for (int w8 = 0; w8 < 8; ++w8) s += part[(w8 * 9 + r) * 64 + cl];
                modv[((size_t)l * 9 + r) * NMODC + cg64 * 64 + cl] = s + pa->in[5][l * NMODC + cg64 * 64 + cl]; }
            __syncthreads();
        }
    }
    LAS float* scr = (LAS float*)(lds + 65536 + wave * 8704);
    const int gw = bx * NWAVES + wave, NGW = G * NWAVES;
    constexpr int I_GU = 16 * 176, I_DN = 44 * 32, I_IN = 16 * 168, I_OA = 6 * 32, I_OC = 4 * 32, I_WO = 16 * 32, I_L = 2 * I_GU + 2 * I_DN + I_IN + 2 * I_OA + I_OC + I_WO;
    for (int it = gw; it < 2 * I_L; it += NGW) {
        const int l = it / I_L; int r = it - l * I_L;
        bf16* wl = (bf16*)(pa->ws + WS_W) + (size_t)l * WL_ELEMS;
        if (r < 2 * (I_GU + I_DN)) {
            const int f = r / (I_GU + I_DN); r -= f * (I_GU + I_DN);
            if (r < I_GU) { const int kb = r / 176, nb = r % 176; transpose_item(pa->in[7 + 2 * f] + (size_t)l * DM * 2 * DFF, DM, 2 * DFF, wl + (f ? WO_GU2 : WO_GU1), 64 * kb, 32 * nb, gu_row(32 * nb), scr, lane); }
            else { r -= I_GU; const int kb = r / 32, nb = r % 32; transpose_item(pa->in[8 + 2 * f] + (size_t)l * DFF * DM, DFF, DM, wl + (f ? WO_DN2 : WO_DN1), 64 * kb, 32 * nb, 32 * nb, scr, lane); }
            continue;
        }
        r -= 2 * (I_GU + I_DN);
        if (r < I_IN) { const int kb = r / 168, nb = r % 168; transpose_item(pa->in[11] + (size_t)l * DM * IN_DIM, DM, IN_DIM, wl + WO_IN, 64 * kb, 32 * nb, in_row(32 * nb), scr, lane); continue; }
        r -= I_IN;
        if (r < I_OA) { const int kb = r / 32, nb = r % 32; transpose_item(pa->in[19] + (size_t)l * 384 * DM, 384, DM, wl + WO_OA, 64 * kb, 32 * nb, 32 * nb, scr, lane); continue; }
        r -= I_OA;
        if (r < I_OA) { const int kb = r / 32, nb = r % 32; transpose_item(pa->in[20] + (size_t)l * 384 * DM, 384, DM, wl + WO_OB, 64 * kb, 32 * nb, 32 * nb, scr, lane); continue; }
        r -= I_OA;
        if (r < I_OC) { const int kb = r / 32, nb = r % 32; transpose_item(pa->in[21] + (size_t)l * 256 * DM, 256, DM, wl + WO_OC, 64 * kb, 32 * nb, 32 * nb, scr, lane); continue; }
        r -= I_OC;
        { const int kb = r / 32, nb = r % 32; transpose_item(pa->in[22] + (size_t)l * DM * DM, DM, DM, wl + WO_WO, 64 * kb, 32 * nb, 32 * nb, scr, lane); }
    }
}

__device__ __forceinline__ void row_load(f32x4 (&v)[4], const void* base, size_t row, bool f32src, int lane) {
    if (f32src) {
#pragma unroll
        for (int j = 0; j < 4; ++j) v[j] = *((const f32x4*)((const float*)base + row * DM) + lane + 64 * j);
    } else {
#pragma unroll
        for (int j = 0; j < 4; ++j) { const u32x2 w = *((const u32x2*)((const bf16*)base + row * DM) + lane + 64 * j); v[j] = pg8::bflo(w.x, w.y); }
    }
}
__device__ __forceinline__ void ctx_reduce(f32x4 (&v)[4], int rc, const float* part, const float* pgate, float coef, bf16* xc_out, int lane) {
#pragma unroll
    for (int j = 0; j < 4; ++j) {
        f32x4 s = *((const f32x4*)(part + (size_t)rc * DM) + lane + 64 * j);
#pragma unroll
        for (int sl = 1; sl < 8; ++sl) s = s + *((const f32x4*)(part + ((size_t)sl * MCTX + rc) * DM) + lane + 64 * j);
        v[j] = v[j] + *((const f32x4*)pgate + lane + 64 * j) * coef * s;
        ((unsigned long long*)(xc_out + (size_t)rc * DM))[lane + 64 * j] = (unsigned long long)pk2(v[j][0], v[j][1]) | ((unsigned long long)pk2(v[j][2], v[j][3]) << 32);
    }
}
__device__ __forceinline__ void norm_phase(const void* xl, const void* xc, bool f32src, bool f32ctx, const float* g, const float* modl, int shift_q, int scale_q, bf16* H, int nrows,
                                           const float* part, const float* pgate, float coef, bf16* xc_out, int lane, int wave) {
    const int gw = blockIdx.x * NWAVES + wave, NGW = gridDim.x * NWAVES;
    f32x4 gv[4];
#pragma unroll
    for (int j = 0; j < 4; ++j) gv[j] = *((const f32x4*)g + lane + 64 * j);
    for (int r0 = gw; r0 < nrows; r0 += 2 * NGW) {
        const int r1 = r0 + NGW; const bool has1 = r1 < nrows; const int r1c = has1 ? r1 : r0;
        f32x4 v0[4], v1[4]; float s0 = 0.f, s1 = 0.f;
        row_load(v0, r0 < MLAT ? xl : xc, (size_t)(r0 < MLAT ? r0 : r0 - MLAT), r0 < MLAT ? f32src : f32ctx, lane);
        row_load(v1, r1c < MLAT ? xl : xc, (size_t)(r1c < MLAT ? r1c : r1c - MLAT), r1c < MLAT ? f32src : f32ctx, lane);
        if (part && r0 >= MLAT) ctx_reduce(v0, r0 - MLAT, part, pgate, coef, xc_out, lane);
        if (part && has1 && r1 >= MLAT) ctx_reduce(v1, r1 - MLAT, part, pgate, coef, xc_out, lane);
#pragma unroll
        for (int j = 0; j < 4; ++j) { s0 += (v0[j][0] * v0[j][0] + v0[j][1] * v0[j][1]) + (v0[j][2] * v0[j][2] + v0[j][3] * v0[j][3]); s1 += (v1[j][0] * v1[j][0] + v1[j][1] * v1[j][1]) + (v1[j][2] * v1[j][2] + v1[j][3] * v1[j][3]); }
        const float rstd0 = 1.f / sqrtf(wave_sum(s0) * (1.f / DM) + RMS_EPS), rstd1 = 1.f / sqrtf(wave_sum(s1) * (1.f / DM) + RMS_EPS);
        const float* mv0 = modl + (r0 < MLAT ? (r0 >> 12) : 8) * NMODC; const float* mv1 = modl + (r1c < MLAT ? (r1c >> 12) : 8) * NMODC;
        unsigned long long* o0 = (unsigned long long*)(H + (size_t)r0 * DM) + lane; unsigned long long* o1 = (unsigned long long*)(H + (size_t)r1c * DM) + lane;
#pragma unroll
        for (int j = 0; j < 4; ++j) {
            const f32x4 sh0 = *((const f32x4*)(mv0 + shift_q * DM) + lane + 64 * j), sc0 = *((const f32x4*)(mv0 + scale_q * DM) + lane + 64 * j);
            const f32x4 y0 = v0[j] * rstd0 * gv[j] * (sc0 + 1.f) + sh0;
            o0[64 * j] = (unsigned long long)pk2(y0[0], y0[1]) | ((unsigned long long)pk2(y0[2], y0[3]) << 32);
            if (has1) {
                const f32x4 sh1 = *((const f32x4*)(mv1 + shift_q * DM) + lane + 64 * j), sc1 = *((const f32x4*)(mv1 + scale_q * DM) + lane + 64 * j);
                const f32x4 y1 = v1[j] * rstd1 * gv[j] * (sc1 + 1.f) + sh1;
                o1[64 * j] = (unsigned long long)pk2(y1[0], y1[1]) | ((unsigned long long)pk2(y1[2], y1[3]) << 32);
            }
        }
    }
}
__device__ __forceinline__ void final_norm(const bf16* x, float* out, const float* g, int lane, int wave) {
    const int gw = blockIdx.x * NWAVES + wave, NGW = gridDim.x * NWAVES;
    f32x4 gv[4];
#pragma unroll
    for (int j = 0; j < 4; ++j) gv[j] = *((const f32x4*)g + lane + 64 * j);
    for (int r = gw; r < MLAT; r += NGW) {
        f32x4 v[4]; float s = 0.f;
        row_load(v, x, (size_t)r, false, lane);
#pragma unroll
        for (int j = 0; j < 4; ++j) s += (v[j][0] * v[j][0] + v[j][1] * v[j][1]) + (v[j][2] * v[j][2] + v[j][3] * v[j][3]);
        const float rstd = 1.f / sqrtf(wave_sum(s) * (1.f / DM) + RMS_EPS);
        f32x4* orow = (f32x4*)(out + (size_t)r * DM) + lane;
#pragma unroll
        for (int j = 0; j < 4; ++j) orow[64 * j] = v[j] * rstd * gv[j];
    }
}

#define MFMA16(a, b, c) __builtin_amdgcn_mfma_f32_16x16x32_bf16((a), (b), (c), 0, 0, 0)
#define AINL __attribute__((always_inline))
template <int NQ> struct AQ { bf16x8 qf[NQ][2]; float m[NQ], l[NQ]; f32x4 o[NQ][4]; };
struct KF { bf16x8 ka[2], kb[2]; };
struct VF { bf16x8 v[4]; };
__device__ __forceinline__ void k_load(KF& d, const bf16* kpa, const bf16* kpb) {
    d.ka[0] = *(const bf16x8*)kpa; d.ka[1] = *(const bf16x8*)(kpa + 32); d.kb[0] = *(const bf16x8*)kpb; d.kb[1] = *(const bf16x8*)(kpb + 32);
}
__device__ __forceinline__ void v_load(VF& d, const bf16* va, const bf16* vb) {
#pragma unroll
    for (int nb = 0; nb < 4; ++nb) { const u32x2 x = *(const u32x2*)(va + (size_t)nb * 16 * MALL), y = *(const u32x2*)(vb + (size_t)nb * 16 * MALL);
        u32x4 vw; vw.x = x.x; vw.y = x.y; vw.z = y.x; vw.w = y.y; d.v[nb] = __builtin_bit_cast(bf16x8, vw); }
}
template <int NQ> __device__ __forceinline__ void aq_init(AQ<NQ>& A) {
#pragma unroll
    for (int q = 0; q < NQ; ++q) { A.m[q] = NEGB; A.l[q] = 0.f;
#pragma unroll
        for (int nb = 0; nb < 4; ++nb) A.o[q][nb] = (f32x4){0.f, 0.f, 0.f, 0.f}; }
}
template <int NQ, class G, class F> __device__ __forceinline__ void pair_compute(AQ<NQ>& A, const KF& c, const VF& cv, G&& act, F&& f) {
    bf16x8 pf[NQ];
#pragma unroll
    for (int q = 0; q < NQ; ++q) {
        if (!act(q)) continue;
        f32x4 sa = {0.f, 0.f, 0.f, 0.f}, sb = {0.f, 0.f, 0.f, 0.f};
        sa = MFMA16(c.ka[0], A.qf[q][0], sa); sa = MFMA16(c.ka[1], A.qf[q][1], sa);
        sb = MFMA16(c.kb[0], A.qf[q][0], sb); sb = MFMA16(c.kb[1], A.qf[q][1], sb);
        f(q, sa, sb);
        float mx = fmaxf(fmaxf(fmaxf(sa[0], sa[1]), fmaxf(sa[2], sa[3])), fmaxf(fmaxf(sb[0], sb[1]), fmaxf(sb[2], sb[3])));
        mx = fmaxf(mx, __shfl_xor(mx, 16)); mx = fmaxf(mx, __shfl_xor(mx, 32));
        const float mn = fmaxf(A.m[q], mx), sc = ex2(A.m[q] - mn);
        A.m[q] = mn;
#pragma unroll
        for (int nb = 0; nb < 4; ++nb) A.o[q][nb] = A.o[q][nb] * sc;
#pragma unroll
        for (int i = 0; i < 4; ++i) { sa[i] = ex2(sa[i] - mn); sb[i] = ex2(sb[i] - mn); }
        A.l[q] = A.l[q] * sc + ((sa[0] + sa[1]) + (sa[2] + sa[3])) + ((sb[0] + sb[1]) + (sb[2] + sb[3]));
        u32x4 pw; pw.x = pk2(sa[0], sa[1]); pw.y = pk2(sa[2], sa[3]); pw.z = pk2(sb[0], sb[1]); pw.w = pk2(sb[2], sb[3]);
        pf[q] = __builtin_bit_cast(bf16x8, pw);
    }
#pragma unroll
    for (int q = 0; q < NQ; ++q) {
        if (!act(q)) continue;
#pragma unroll
        for (int nb = 0; nb < 4; ++nb) A.o[q][nb] = MFMA16(cv.v[nb], pf[q], A.o[q][nb]);
    }
}
template <class LD, class ST> __device__ __forceinline__ void pingpong(int n, LD&& ld, ST&& st) {
    KF k0, k1;
    ld(k0, 0);
    int t = 0;
#pragma unroll 1
    for (; t + 1 < n; t += 2) {
        ld(k1, t + 1);
        st(k0, t);
        ld(k0, min(t + 2, n - 1));
        st(k1, t + 1);
    }
    if (t < n) st(k0, t);
}
template <int NQ> __device__ __forceinline__ void ctx_chunk(AQ<NQ>& A, const bf16* kp, int ldk, const bf16* vp) {
    pingpong(8,
        [&](KF& kf, int t) AINL { k_load(kf, kp + (size_t)(32 * t) * ldk, kp + (size_t)(32 * t + 16) * ldk); },
        [&](const KF& kf, int t) AINL { VF vf; v_load(vf, vp + 32 * t, vp + 32 * t + 16); pair_compute<NQ>(A, kf, vf, [](int) AINL { return true; }, [](int, f32x4&, f32x4&) AINL {}); });
}
__device__ __forceinline__ void attn_store1(const f32x4 (&o)[4], float l, bf16* yp  ) {
    l += __shfl_xor(l, 16); l += __shfl_xor(l, 32);
    const float inv = 1.f / l;
#pragma unroll
    for (int nb = 0; nb < 4; ++nb) { u32x2 w; w.x = pk2(o[nb][0] * inv, o[nb][1] * inv); w.y = pk2(o[nb][2] * inv, o[nb][3] * inv); *(u32x2*)(yp + 16 * nb) = w; }
}
template <int NQ> __device__ __forceinline__ void sink_fold(AQ<NQ>& A, const float* sink, int h0, int fq) {
#pragma unroll
    for (int q = 0; q < NQ; ++q) { const float sk = sink[h0 + q] * LOG2E, mn = fmaxf(A.m[q], sk), sc = ex2(A.m[q] - mn); A.l[q] *= sc;
#pragma unroll
        for (int nb = 0; nb < 4; ++nb) A.o[q][nb] = A.o[q][nb] * sc;
        if (fq == 0) A.l[q] += ex2(sk - mn); }
}

struct AttnBufs { const bf16 *QA, *KA, *QB, *KB, *VT; bf16 *YA, *YB; };

__device__ __forceinline__ void na_unit(const AttnBufs& T, const LAS float* btab, int b, int h, int j, int rp, int fr, int fq) {
    const int hoff = h * 64, r0 = 2 * rp;
    AQ<2> A; aq_init<2>(A);
#pragma unroll
    for (int q = 0; q < 2; ++q) { const bf16* qp = T.QA + (size_t)(b * SEQ + (r0 + q) * 64 + 16 * j + fr) * 384 + hoff + 8 * fq; A.qf[q][0] = *(const bf16x8*)qp; A.qf[q][1] = *(const bf16x8*)(qp + 32); }
    const int ka0 = min(max(r0 - 4, 0), 56), kb0 = min(max(r0 - 3, 0), 56), nrow = kb0 - ka0 + 8, c0 = min(max(16 * j - 8, 0), 32);
    const int c = 16 * j + fr, w0 = min(max(c - 8, 0), 48);
    int dxo[8];
#pragma unroll
    for (int e = 0; e < 8; ++e) { const int kc = c0 + 16 * (e >> 2) + 4 * fq + (e & 3); const bool in = (kc >= w0) && (kc < w0 + 16); dxo[e] = in ? min(max(kc - c + 15, 0), 30) : 31; }
    {
        const int tk0 = b * SEQ + ka0 * 64 + c0;
        const bf16* kp = T.KA + (size_t)(tk0 + fr) * 384 + hoff + 8 * fq;
        const bf16* vp = T.VT + (size_t)(hoff + fr) * MALL + tk0 + 4 * fq;
        const LAS float* bh = btab + h * (15 * 32);
        pingpong(nrow,
            [&](KF& kf, int t) AINL { k_load(kf, kp + (size_t)(t * 64) * 384, kp + (size_t)(t * 64 + 16) * 384); },
            [&](const KF& kf, int t) AINL {
            VF vf; v_load(vf, vp + t * 64, vp + t * 64 + 16);
            const int ky = ka0 + t;
            pair_compute<2>(A, kf, vf,
                [&](int q) AINL { const int k0 = q ? kb0 : ka0; return (ky >= k0) && (ky < k0 + 8); },
                [&](int q, f32x4& sa, f32x4& sb) AINL {
                    const LAS float* rp_ = bh + (ky - (r0 + q) + 7) * 32;
#pragma unroll
                    for (int i = 0; i < 4; ++i) { sa[i] += rp_[dxo[i]]; sb[i] += rp_[dxo[4 + i]]; } }); });
    }
    ctx_chunk<2>(A, T.KA + (size_t)(MLAT + b * CTXL + fr) * 384 + hoff + 8 * fq, 384, T.VT + (size_t)(hoff + fr) * MALL + MLAT + b * CTXL + 4 * fq);
#pragma unroll
    for (int q = 0; q < 2; ++q) attn_store1(A.o[q], A.l[q], T.YA + (size_t)(b * SEQ + (r0 + q) * 64 + 16 * j + fr) * 384 + hoff + 4 * fq);
}
__device__ __forceinline__ void sw_unit(const AttnBufs& T, const float* sink, int b, int kvh, int qb, int fr, int fq) {
    const int q0 = 16 * qb, tq0 = b * SEQ + q0, khoff = kvh * 64, h0 = 3 * kvh;
    AQ<3> A; aq_init<3>(A);
#pragma unroll
    for (int q = 0; q < 3; ++q) { const bf16* qp = T.QB + (size_t)(tq0 + fr) * 384 + (h0 + q) * 64 + 8 * fq; A.qf[q][0] = *(const bf16x8*)qp; A.qf[q][1] = *(const bf16x8*)(qp + 32); }
    {
        const int tq = q0 + fr;
        const bool edge = (q0 < 128) || (q0 + 160 > SEQ);
        const bf16* kbase = T.KB + (size_t)(b * SEQ) * 128 + khoff + 8 * fq;
        const bf16* vrow = T.VT + (size_t)(384 + khoff + fr) * MALL + b * SEQ;
#define SW_KLOAD(dst, t) do { const int ka_ = q0 - 128 + 32 * (t); \
            k_load(dst, kbase + (size_t)min(max(ka_ + fr, 0), SEQ - 1) * 128, kbase + (size_t)min(max(ka_ + 16 + fr, 0), SEQ - 1) * 128); } while (0)
#define SW_VLOAD(dst, t) do { const int ka_ = q0 - 128 + 32 * (t); \
            v_load(dst, vrow + min(max(ka_ + 4 * fq, 0), SEQ - 4), vrow + min(max(ka_ + 16 + 4 * fq, 0), SEQ - 4)); } while (0)
        pingpong(9,
            [&](KF& kf, int t) AINL { SW_KLOAD(kf, t); },
            [&](const KF& kf, int t) AINL {
            VF vf; SW_VLOAD(vf, t);
            const int kt0 = q0 - 128 + 32 * t;
            const bool need = edge || (t == 0) || (t == 8);
            pair_compute<3>(A, kf, vf, [](int) AINL { return true; }, [&](int, f32x4& sa, f32x4& sb) AINL {
                if (need) {
#pragma unroll
                    for (int i = 0; i < 4; ++i) {
                        { const int tk = kt0 + 4 * fq + i, d = tq - tk; const bool ok = (d <= 128) && (d >= -128) && (tk >= 0) && (tk < SEQ); sa[i] = ok ? sa[i] : NEGB; }
                        { const int tk = kt0 + 16 + 4 * fq + i, d = tq - tk; const bool ok = (d <= 128) && (d >= -128) && (tk >= 0) && (tk < SEQ); sb[i] = ok ? sb[i] : NEGB; }
                    } } }); });
#undef SW_KLOAD
#undef SW_VLOAD
    }
    ctx_chunk<3>(A, T.KB + (size_t)(MLAT + b * CTXL + fr) * 128 + khoff + 8 * fq, 128, T.VT + (size_t)(384 + khoff + fr) * MALL + MLAT + b * CTXL + 4 * fq);
    sink_fold<3>(A, sink, h0, fq);
#pragma unroll
    for (int q = 0; q < 3; ++q) attn_store1(A.o[q], A.l[q], T.YB + (size_t)(tq0 + fr) * 384 + (h0 + q) * 64 + 4 * fq);
}
__device__ __forceinline__ void ctxa_unit(const AttnBufs& T, int b, int h, int qb, int fr, int fq) {
    const int tq0 = MLAT + b * CTXL + 16 * qb, hoff = h * 64;
    AQ<1> A; aq_init<1>(A);
    { const bf16* qp = T.QA + (size_t)(tq0 + fr) * 384 + hoff + 8 * fq; A.qf[0][0] = *(const bf16x8*)qp; A.qf[0][1] = *(const bf16x8*)(qp + 32); }
    ctx_chunk<1>(A, T.KA + (size_t)(MLAT + b * CTXL + fr) * 384 + hoff + 8 * fq, 384, T.VT + (size_t)(hoff + fr) * MALL + MLAT + b * CTXL + 4 * fq);
    attn_store1(A.o[0], A.l[0], T.YA + (size_t)(tq0 + fr) * 384 + hoff + 4 * fq);
}
__device__ __forceinline__ void ctxb_unit(const AttnBufs& T, const float* sink, int b, int kvh, int qb, int fr, int fq) {
    const int tq0 = MLAT + b * CTXL + 16 * qb, khoff = kvh * 64, h0 = 3 * kvh;
    AQ<3> A; aq_init<3>(A);
#pragma unroll
    for (int q = 0; q < 3; ++q) { const bf16* qp = T.QB + (size_t)(tq0 + fr) * 384 + (h0 + q) * 64 + 8 * fq; A.qf[q][0] = *(const bf16x8*)qp; A.qf[q][1] = *(const bf16x8*)(qp + 32); }
    ctx_chunk<3>(A, T.KB + (size_t)(MLAT + b * CTXL + fr) * 128 + khoff + 8 * fq, 128, T.VT + (size_t)(384 + khoff + fr) * MALL + MLAT + b * CTXL + 4 * fq);
    sink_fold<3>(A, sink, h0, fq);
#pragma unroll
    for (int q = 0; q < 3; ++q) attn_store1(A.o[q], A.l[q], T.YB + (size_t)(tq0 + fr) * 384 + (h0 + q) * 64 + 4 * fq);
}
constexpr int LWL = 0, LBT = 64512, LK = 76800, SROW = 144, SBUF = 64 * SROW, LBU = LK + 6 * SBUF;
struct Stage { u32x4 k, v; };
__device__ __forceinline__ void stage_load(Stage& s, const bf16* kg, const bf16* vg) { s.k = *(const u32x4*)kg; s.v = *(const u32x4*)vg; }
__device__ __forceinline__ void stage_write(LAS unsigned char* buf, const Stage& s, int tid) { const int o = (tid >> 3) * SROW + (tid & 7) * 16; *(LAS u32x4*)(buf + o) = s.k; *(LAS u32x4*)(buf + SBUF + o) = s.v; }
__device__ __forceinline__ void lds_kf(KF& d, const LAS unsigned char* kb, int tokoff, int fr, int fq) {
    const LAS unsigned char* p = kb + (tokoff + fr) * SROW + fq * 16;
    d.ka[0] = *(const LAS bf16x8*)p; d.ka[1] = *(const LAS bf16x8*)(p + 64); d.kb[0] = *(const LAS bf16x8*)(p + 16 * SROW); d.kb[1] = *(const LAS bf16x8*)(p + 16 * SROW + 64);
}
__device__ __forceinline__ void lds_vf(VF& d, const LAS unsigned char* vb, int tokoff, int fr, int fq) {
#pragma unroll
    for (int nb = 0; nb < 4; ++nb) { const LAS unsigned char* p = vb + (fr + 16 * nb) * SROW + (tokoff + 4 * fq) * 2; const u32x2 x = *(const LAS u32x2*)p, y = *(const LAS u32x2*)(p + 32);
        u32x4 vw; vw.x = x.x; vw.y = x.y; vw.z = y.x; vw.w = y.y; d.v[nb] = __builtin_bit_cast(bf16x8, vw); }
}
template <int NQ, class F> __device__ __forceinline__ void set_step(AQ<NQ>& A, const int q, const KF& c, const VF& cv, F&& f) {
    f32x4 sa = {0.f, 0.f, 0.f, 0.f}, sb = {0.f, 0.f, 0.f, 0.f};
    sa = MFMA16(c.ka[0], A.qf[q][0], sa); sa = MFMA16(c.ka[1], A.qf[q][1], sa);
    sb = MFMA16(c.kb[0], A.qf[q][0], sb); sb = MFMA16(c.kb[1], A.qf[q][1], sb);
    f(sa, sb);
    float mx = fmaxf(fmaxf(fmaxf(sa[0], sa[1]), fmaxf(sa[2], sa[3])), fmaxf(fmaxf(sb[0], sb[1]), fmaxf(sb[2], sb[3])));
    mx = fmaxf(mx, __shfl_xor(mx, 16)); mx = fmaxf(mx, __shfl_xor(mx, 32));
    const float mn = fmaxf(A.m[q], mx), sc = ex2(A.m[q] - mn);
    A.m[q] = mn;
#pragma unroll
    for (int nb = 0; nb < 4; ++nb) A.o[q][nb] = A.o[q][nb] * sc;
#pragma unroll
    for (int i = 0; i < 4; ++i) { sa[i] = ex2(sa[i] - mn); sb[i] = ex2(sb[i] - mn); }
    A.l[q] = A.l[q] * sc + ((sa[0] + sa[1]) + (sa[2] + sa[3])) + ((sb[0] + sb[1]) + (sb[2] + sb[3]));
    u32x4 pw; pw.x = pk2(sa[0], sa[1]); pw.y = pk2(sa[2], sa[3]); pw.z = pk2(sb[0], sb[1]); pw.w = pk2(sb[2], sb[3]);
    const bf16x8 pf = __builtin_bit_cast(bf16x8, pw);
#pragma unroll
    for (int nb = 0; nb < 4; ++nb) A.o[q][nb] = MFMA16(cv.v[nb], pf, A.o[q][nb]);
}
template <class SRC, class CMP> __device__ __forceinline__ void chunk_pipeline(LAS unsigned char* lds, int n, int tid, SRC&& src, CMP&& cmp) {
    Stage sA, sB; const bf16* kg; const bf16* vg;
    { Stage s0; src(0, kg, vg); stage_load(s0, kg, vg);
      if (n > 1) { src(1, kg, vg); stage_load(sA, kg, vg); }
      if (n > 2) { src(2, kg, vg); stage_load(sB, kg, vg); }
      stage_write(lds + LK, s0, tid); }
    __syncthreads();
    int i = 0, bi = 0;
#pragma unroll 1
    for (;;) {
        { LAS unsigned char* cur = lds + LK + bi * 2 * SBUF; const int bn = bi == 2 ? 0 : bi + 1;
          cmp(i, cur, cur + SBUF);
          if (i + 1 < n) stage_write(lds + LK + bn * 2 * SBUF, sA, tid);
          if (i + 3 < n) { src(i + 3, kg, vg); stage_load(sA, kg, vg); }
          __syncthreads(); ++i; bi = bn; if (i >= n) break; }
        { LAS unsigned char* cur = lds + LK + bi * 2 * SBUF; const int bn = bi == 2 ? 0 : bi + 1;
          cmp(i, cur, cur + SBUF);
          if (i + 1 < n) stage_write(lds + LK + bn * 2 * SBUF, sB, tid);
          if (i + 3 < n) { src(i + 3, kg, vg); stage_load(sB, kg, vg); }
          __syncthreads(); ++i; bi = bn; if (i >= n) break; }
    }
}
__device__ __forceinline__ void sw_block(const AttnBufs& T, const float* sink, LAS unsigned char* lds, int b, int kvh, int qblk, int tid, int wave, int fr, int fq) {
    const int q0 = 128 * qblk, wq0 = q0 + 16 * wave, tq0 = b * SEQ + wq0, khoff = kvh * 64, h0 = 3 * kvh;
    AQ<3> A; aq_init<3>(A);
#pragma unroll
    for (int q = 0; q < 3; ++q) { const bf16* qp = T.QB + (size_t)(tq0 + fr) * 384 + (h0 + q) * 64 + 8 * fq; A.qf[q][0] = *(const bf16x8*)qp; A.qf[q][1] = *(const bf16x8*)(qp + 32); }
    const int c_lo = q0 < 128 ? 2 : 0, c_hi = q0 + 256 > SEQ ? 4 : 6, nl = c_hi - c_lo;
    const int srow = tid >> 3, sseg = (tid & 7) * 8;
    chunk_pipeline(lds, nl + 4, tid,
        [&](int i, const bf16*& kg, const bf16*& vg) AINL {
            const int t0 = i < nl ? b * SEQ + q0 - 128 + 64 * (c_lo + i) : MLAT + b * CTXL + 64 * (i - nl);
            kg = T.KB + (size_t)(t0 + srow) * 128 + khoff + sseg; vg = T.VT + (size_t)(384 + khoff + srow) * MALL + t0 + sseg; },
        [&](int i, const LAS unsigned char* kb, const LAS unsigned char* vb) AINL {
            const bool loc = i < nl; const int t0 = q0 - 128 + 64 * (c_lo + i);
#pragma unroll
            for (int p = 0; p < 2; ++p) {
                const int ps = t0 + 32 * p;
                if (loc && !((ps + 31 >= wq0 - 128) && (ps <= wq0 + 15 + 128))) continue;
                const bool need = loc && !((ps >= wq0 + 15 - 128) && (ps + 31 <= wq0 + 128));
                KF kf; VF vf; lds_kf(kf, kb, 32 * p, fr, fq); lds_vf(vf, vb, 32 * p, fr, fq);
#pragma unroll
                for (int q = 0; q < 3; ++q) set_step<3>(A, q, kf, vf, [&](f32x4& sa, f32x4& sb) AINL {
                    if (need) {
#pragma unroll
                        for (int e = 0; e < 4; ++e) { const int da = (wq0 + fr) - (ps + 4 * fq + e), db = da - 16; sa[e] = (da <= 128 && da >= -128) ? sa[e] : NEGB; sb[e] = (db <= 128 && db >= -128) ? sb[e] : NEGB; }
                    } });
            } });
    sink_fold<3>(A, sink, h0, fq);
#pragma unroll
    for (int q = 0; q < 3; ++q) attn_store1(A.o[q], A.l[q], T.YB + (size_t)(tq0 + fr) * 384 + (h0 + q) * 64 + 4 * fq);
}
__device__ __forceinline__ void na_block(const AttnBufs& T, const LAS float* btab, LAS unsigned char* lds, int b, int h, int g, int tid, int wave, int fr, int fq) {
    const int hoff = h * 64, r = 4 * g + (wave >> 1), jb = 2 * (wave & 1), tq0 = b * SEQ + r * 64 + 16 * jb;
    AQ<2> A; aq_init<2>(A);
    unsigned dxp[2][2];
    int c0s[2];
#pragma unroll
    for (int jj = 0; jj < 2; ++jj) {
        const int j = jb + jj;
        const bf16* qp = T.QA + (size_t)(tq0 + 16 * jj + fr) * 384 + hoff + 8 * fq; A.qf[jj][0] = *(const bf16x8*)qp; A.qf[jj][1] = *(const bf16x8*)(qp + 32);
        const int c = 16 * j + fr, w0 = min(max(c - 8, 0), 48), c0 = min(max(16 * j - 8, 0), 32);
        c0s[jj] = c0;
#pragma unroll
        for (int x = 0; x < 2; ++x) { unsigned w = 0;
#pragma unroll
            for (int e = 0; e < 4; ++e) { const int kc = c0 + 16 * x + 4 * fq + e; const bool in = (kc >= w0) && (kc < w0 + 16); const int dx = in ? min(max(kc - c + 15, 0), 30) : 31; w |= (unsigned)(4 * dx) << (8 * e); }
            dxp[jj][x] = w; }
    }
    const int kr0 = min(max(r - 4, 0), 56), ku0 = min(max(4 * g - 4, 0), 56), nl = min(max(4 * g - 1, 0), 56) + 8 - ku0;
    const int srow = tid >> 3, sseg = (tid & 7) * 8;
    const LAS unsigned char* bh = (const LAS unsigned char*)(btab + h * (15 * 32));
    chunk_pipeline(lds, nl + 4, tid,
        [&](int i, const bf16*& kg, const bf16*& vg) AINL {
            const int t0 = i < nl ? b * SEQ + (ku0 + i) * 64 : MLAT + b * CTXL + 64 * (i - nl);
            kg = T.KA + (size_t)(t0 + srow) * 384 + hoff + sseg; vg = T.VT + (size_t)(hoff + srow) * MALL + t0 + sseg; },
        [&](int i, const LAS unsigned char* kb, const LAS unsigned char* vb) AINL {
            if (i < nl) {
                const int ky = ku0 + i;
                if ((ky >= kr0) && (ky < kr0 + 8)) {
                    const LAS unsigned char* rp_ = bh + (ky - r + 7) * 128;
#pragma unroll
                    for (int jj = 0; jj < 2; ++jj) {
                        KF kf; VF vf; lds_kf(kf, kb, c0s[jj], fr, fq); lds_vf(vf, vb, c0s[jj], fr, fq);
                        set_step<2>(A, jj, kf, vf, [&](f32x4& sa, f32x4& sb) AINL {
#pragma unroll
                            for (int e = 0; e < 4; ++e) { sa[e] += *(const LAS float*)(rp_ + ((dxp[jj][0] >> (8 * e)) & 0xffu)); sb[e] += *(const LAS float*)(rp_ + ((dxp[jj][1] >> (8 * e)) & 0xffu)); } });
                    }
                }
            } else {
#pragma unroll
                for (int p = 0; p < 2; ++p) { KF kf; VF vf; lds_kf(kf, kb, 32 * p, fr, fq); lds_vf(vf, vb, 32 * p, fr, fq);
#pragma unroll
                    for (int jj = 0; jj < 2; ++jj) set_step<2>(A, jj, kf, vf, [](f32x4&, f32x4&) AINL {}); }
            } });
#pragma unroll
    for (int jj = 0; jj < 2; ++jj) attn_store1(A.o[jj], A.l[jj], T.YA + (size_t)(tq0 + 16 * jj + fr) * 384 + hoff + 4 * fq);
}

__device__ __forceinline__ void conv_unit(const bf16* HG, bf16* YC, const LAS float* wl, const float* dwb, const float* lng, const float* lnb, int tok0, int lo, int hi, int lane) {
    const f32x4 bias = *((const f32x4*)dwb + lane);
    f32x4 acc[16];
#pragma unroll
    for (int t = 0; t < 16; ++t) acc[t] = bias;
#pragma unroll 1
    for (int ig = 0; ig < 6; ++ig) {
        u32x2 hv[8];
#pragma unroll
        for (int k = 0; k < 8; ++k) { const int r = tok0 - 15 + 8 * ig + k; hv[k] = (u32x2){0u, 0u}; if (r >= lo && r < hi) hv[k] = *(const u32x2*)(HG + (size_t)r * 256 + 4 * lane); }
#pragma unroll
        for (int k = 0; k < 8; ++k) {
            const f32x4 h = pg8::bflo(hv[k].x, hv[k].y);
            const LAS float* wp = wl + (8 * ig + k + 15) * 256 + 4 * lane;
#pragma unroll
            for (int t = 0; t < 16; ++t) acc[t] = acc[t] + h * *(const LAS f32x4*)(wp - t * 256);
        }
    }
    const f32x4 g = *((const f32x4*)lng + lane), be = *((const f32x4*)lnb + lane);
#pragma unroll
    for (int t = 0; t < 16; ++t) {
        const f32x4 v = acc[t];
        const float mu = wave_sum((v[0] + v[1]) + (v[2] + v[3])) * (1.f / 256.f);
        const f32x4 d = v - mu;
        const float var = wave_sum((d[0] * d[0] + d[1] * d[1]) + (d[2] * d[2] + d[3] * d[3])) * (1.f / 256.f);
        const float rstd = 1.f / sqrtf(var + RMS_EPS);
        const f32x4 y = d * rstd * g + be;
        u32x2 o; o.x = pk2(silu_f(y[0]), silu_f(y[1])); o.y = pk2(silu_f(y[2]), silu_f(y[3]));
        *(u32x2*)(YC + (size_t)(tok0 + t) * 256 + 4 * lane) = o;
    }
}

template <int rep> __device__ __forceinline__ void mixer_phase(KArgs pa, LAS unsigned char* lds, int l, int tid, int lane, int wave) {
    unsigned char* R = pa->ws + WS_R;
    AttnBufs T; T.QA = (const bf16*)(R + R_QA); T.KA = (const bf16*)(R + R_KA); T.QB = (const bf16*)(R + R_QB); T.KB = (const bf16*)(R + R_KB); T.VT = (const bf16*)(R + R_VT);
    T.YA = (bf16*)(R + R_YA); T.YB = (bf16*)(R + R_YB);
    const bf16* HG = (const bf16*)(R + R_HG); bf16* YC = (bf16*)(R + R_YC);
    LAS float* wl = (LAS float*)lds;
    for (int i = tid; i < 63 * 256; i += NTHR) { const int w = (i >> 8) - 15; wl[i] = (w >= 0 && w < 31) ? pa->in[15][l * 31 * 256 + w * 256 + (i & 255)] : 0.f; }
    LAS float* btab = (LAS float*)(lds + LBT);
    for (int i = tid; i < 6 * 15 * 32; i += NTHR) { const int dx = i & 31, hd = i >> 5; btab[i] = dx < 31 ? pa->in[13][l * (6 * 15 * 31) + hd * 31 + dx] * LOG2E : NEGB; }
    __syncthreads();
    const float* sink = pa->in[14] + l * 6;
    const float* dwb = pa->in[16] + l * 256; const float* lng = pa->in[17] + l * 256; const float* lnb = pa->in[18] + l * 256;
    {
        unsigned* ctrb = (unsigned*)(pa->ws + WS_CTR) + 64 * (32 + 2 * rep + l);
        volatile LAS int* bu = (volatile LAS int*)(lds + LBU);
        constexpr int BU_NA = NB * 6 * 16, BU_SW = NB * 2 * 32;
        for (;;) {
            if (tid == 0) *bu = (int)__hip_atomic_fetch_add(ctrb, 1u, __ATOMIC_RELAXED, __HIP_MEMORY_SCOPE_AGENT);
            __syncthreads();
            const int u = __builtin_amdgcn_readfirstlane(*bu);
            __syncthreads();
            if (u >= BU_NA + BU_SW) break;
            int fr = lane & 15, fq = lane >> 4; asm volatile("" : "+v"(fr), "+v"(fq));
            if (u < BU_NA) { const int g = u & 15, bh_ = u >> 4;
#ifndef NO_NAB
 na_block(T, btab, lds, bh_ / 6, bh_ % 6, g, tid, wave, fr, fq);
#endif
 }
            else { const int v = u - BU_NA, qblk = v & 31, bk = v >> 5;
#ifndef NO_SWB
 sw_block(T, sink, lds, bk >> 1, bk & 1, qblk, tid, wave, fr, fq);
#endif
 }
        }
    }
    constexpr int B_CVL = SEQ / 16, B_CXA = 6 * 16, B_CXB = 2 * 16, B_CVC = CTXL / 16;
    const int total = B_CVL + (l == 0 ? B_CXA + B_CXB + B_CVC : 0);
    unsigned* ctr0 = (unsigned*)(pa->ws + WS_CTR) + 64 * 8 * (2 * rep + l);
    const int x0 = (int)((unsigned)__builtin_amdgcn_s_getreg((3 << 11) | 20) & 7u);
    for (int xi = 0; xi < 8; ++xi) {
        const int b = (x0 + xi) & 7;
        unsigned* ctr = ctr0 + 64 * b;
        for (;;) {
            int u = 0; if (lane == 0) u = (int)__hip_atomic_fetch_add(ctr, 1u, __ATOMIC_RELAXED, __HIP_MEMORY_SCOPE_AGENT);
            u = __builtin_amdgcn_readfirstlane(u);
            if (u >= total) break;
            int r = u;
            int fr = lane & 15, fq = lane >> 4; asm volatile("" : "+v"(fr), "+v"(fq));
            if (r < B_CVL) { const int tok0 = b * SEQ + 16 * r; conv_unit(HG, YC, wl, dwb, lng, lnb, tok0, b * SEQ, b * SEQ + SEQ, lane); continue; }
            r -= B_CVL;
            if (r < B_CXA) { const int qb = r & 15, h = r >> 4; ctxa_unit(T, b, h, qb, fr, fq); continue; }
            r -= B_CXA;
            if (r < B_CXB) { const int qb = r & 15, kvh = r >> 4; ctxb_unit(T, sink, b, kvh, qb, fr, fq); continue; }
            r -= B_CXB;
            { const int lo = MLAT + b * CTXL; conv_unit(HG, YC, wl, dwb, lng, lnb, lo + 16 * r, lo, lo + CTXL, lane); }
        }
    }
    __syncthreads();
}

#define RLX_AGENT __ATOMIC_RELAXED, __HIP_MEMORY_SCOPE_AGENT
#define XB_TMO      128
#define XB_XCNT(j)  (256  + 64 * (j))
#define XB_XSUB(j)  (1280 + 64 * (j))
#define XB_XGEN(j)  (2304 + 64 * (j))
#define XB_TOP      3328
#define XB_TOPGEN   3392
#define XCD_BAR_WORDS 3456
#define XB_SPIN_CAP (1u << 18)

__device__ __forceinline__ unsigned xb_ld(unsigned* p)              { return __hip_atomic_load(p, __ATOMIC_RELAXED, __HIP_MEMORY_SCOPE_AGENT); }
__device__ __forceinline__ unsigned xb_add(unsigned* p, unsigned v) { return __hip_atomic_fetch_add(p, v, __ATOMIC_RELAXED, __HIP_MEMORY_SCOPE_AGENT); }
__device__ __forceinline__ unsigned xb_xcc_id() { return (unsigned)__builtin_amdgcn_s_getreg((3 << 11) | 20) & 0xFu; }
#define XB_SPIN(cond, bar) do { unsigned _sp = 0; while (cond) { __builtin_amdgcn_s_sleep(1); \
    if ((++_sp & 255u) == 0u) { if (xb_ld(&(bar)[XB_TMO])) break; if (_sp > XB_SPIN_CAP) { atomicAdd(&(bar)[XB_TMO], 1u); break; } } } } while (0)

struct XcdBarrier {
    unsigned* bar; unsigned x;
    volatile LAS unsigned* st;
};

__device__ __forceinline__ XcdBarrier xcd_barrier_post(unsigned* bar, volatile LAS unsigned* st) {
    XcdBarrier b; b.bar = bar; b.x = xb_xcc_id(); b.st = st;
    if (threadIdx.x == 0) (void)xb_add(&bar[XB_XCNT(b.x)], 1u);
    return b;
}
__device__ __forceinline__ void xcd_barrier_complete(unsigned* bar, unsigned x, unsigned& nloc, unsigned& nx) {
    const unsigned G = gridDim.x * gridDim.y * gridDim.z;
    unsigned sum, cnt, mine, sp = 0u;
    for (;;) {
        sum = 0u; cnt = 0u; mine = 0u;
#pragma unroll
        for (unsigned j = 0; j < 16; ++j) { const unsigned c = xb_ld(&bar[XB_XCNT(j)]); sum += c; cnt += (c > 0u) ? 1u : 0u; mine = (j == x) ? c : mine; }
        if (sum == G) break;
        __builtin_amdgcn_s_sleep(1);
        if ((++sp & 255u) == 0u) { if (xb_ld(&bar[XB_TMO])) break; if (sp > XB_SPIN_CAP) { atomicAdd(&bar[XB_TMO], 1u); break; } }
    }
    nloc = mine > 0u ? mine : 1u; nx = cnt > 0u ? cnt : 1u;
}

__device__ __forceinline__ void xcd_barrier(const XcdBarrier& b) {
    asm volatile("s_waitcnt vmcnt(0)" ::: "memory");
    __syncthreads();
    if (threadIdx.x == 0) {
        unsigned* bar = b.bar;
        __builtin_amdgcn_s_waitcnt(0);
        unsigned nloc = b.st[0], nx = b.st[1];
        if (nloc == 0u) { xcd_barrier_complete(bar, b.x, nloc, nx); b.st[0] = nloc; b.st[1] = nx; }
        const unsigned old = xb_add(&bar[XB_XSUB(b.x)], 1u);
        const unsigned gen = old / nloc;
        if (old + 1u == (gen + 1u) * nloc) {
            __builtin_amdgcn_fence(__ATOMIC_RELEASE, "agent");
            asm volatile("s_waitcnt vmcnt(0)" ::: "memory");
            const unsigned og = xb_add(&bar[XB_TOP], 1u);
            const unsigned tg = og / nx;
            if (og + 1u == (tg + 1u) * nx) xb_add(&bar[XB_TOPGEN], 1u);
            else XB_SPIN(xb_ld(&bar[XB_TOPGEN]) == tg, bar);
            __builtin_amdgcn_fence(__ATOMIC_ACQUIRE, "agent");
            xb_add(&bar[XB_XGEN(b.x)], 1u);
            asm volatile("s_waitcnt vmcnt(0)" ::: "memory");
        } else {
            XB_SPIN(xb_ld(&bar[XB_XGEN(b.x)]) == gen, bar);
            __builtin_amdgcn_fence(__ATOMIC_ACQUIRE, "agent");
            asm volatile("s_waitcnt vmcnt(0)" ::: "memory");
        }
    }
    __syncthreads();
}

#ifdef NO_GEMM
#define GEMM_PHASE(EPI, g, S, E) do { (void)g; (void)S; (void)E; } while (0)
#else
#define GEMM_PHASE(EPI, g, S, E) pg8::gemm_phase<EPI, pg8::StaticOrder, true, true>(ldsp, g, S, E)
#endif
#define CTX_SPLITK(WDN) do { _Pragma("unroll 1") for (int sl = 0; sl < 8; ++sl) { const int kt0 = sl < 6 ? 6 * sl : 36 + 4 * (sl - 6), ntk = sl < 6 ? 6 : 4; \
        pg8::Gemm g2{(const bf16*)R + (size_t)MLAT * DFF + kt0 * 64, (WDN) + kt0 * 64, MCTX, DM, DFF, ntk * 64}; \
        pg8::StaticOrder S2; S2.init(MCTX, DM, G, (bx >= 32 * sl && bx < 32 * sl + 32) ? bx - 32 * sl : (1 << 28)); \
        pg8::EpiF32 E2{(float*)(ws + WS_P) + (size_t)sl * MCTX * DM, DM}; GEMM_PHASE(pg8::EpiF32, g2, S2, E2); } } while (0)

__global__ void __launch_bounds__(NTHR, 2) mk_fwd(Args a_unused) {
    extern __shared__ __attribute__((aligned(16))) unsigned char lds_raw[];
    LAS unsigned char* ldsp = (LAS unsigned char*)lds_raw;
    cg::grid_group grid = cg::this_grid();
#define IN(k) (pa->ph_lo <= (k) && (k) < pa->ph_hi)
#define SEAM(k) do { KArgs pa = kargs(); if (IN(k) && IN((k) + 1)) { XcdBarrier b_; b_.bar = (unsigned*)(pa->ws + WS_BAR); b_.x = xb_xcc_id(); b_.st = (volatile LAS unsigned*)(ldsp + LDS_ST); xcd_barrier(b_); } } while (0)
#define PH_BEGIN(k) { KArgs pa = kargs(); if (IN(k)) { unsigned char* ws = pa->ws; const int G = gridDim.x, bx = blockIdx.x; \
        int tid_l = threadIdx.x; asm volatile("" : "+v"(tid_l)); const int tid = tid_l, lane = tid & 63, wave = __builtin_amdgcn_readfirstlane(tid >> 6); (void)lane; (void)wave; \
        const bf16* W = (const bf16*)(ws + WS_W) + (size_t)l * WL_ELEMS; const float* modl = (const float*)(ws + WS_MOD) + (size_t)l * 9 * NMODC; \
        bf16* X = (bf16*)(ws + WS_XB); bf16* XC = (bf16*)(ws + WS_XC); bf16* H = (bf16*)(ws + WS_H); unsigned char* R = ws + WS_R; bf16* P = (bf16*)(ws + WS_P); \
        const int MP = (l == 1) ? MLAT : MALL; (void)G; (void)bx; (void)W; (void)modl; (void)X; (void)XC; (void)H; (void)R; (void)P; (void)MP;
#define PH_END(k) } } SEAM(k);
#ifndef REPMASK
#define REPMASK 0
#endif
#define REPK(kind) for (int rep_ = 0; rep_ < 1 + ((REPMASK >> (kind)) & 1); ++rep_)

        if (threadIdx.x < 2) ((volatile LAS unsigned*)(ldsp + LDS_ST))[threadIdx.x] = 0u;
    __syncthreads();
    { const int l = 0; PH_BEGIN(0) REPK(0) { prologue(pa, ldsp, tid, lane, wave); __syncthreads(); } } }
      grid.sync();
      { KArgs pa = kargs(); (void)xcd_barrier_post((unsigned*)(pa->ws + WS_BAR), (volatile LAS unsigned*)(ldsp + LDS_ST)); } }
#pragma unroll 1
    for (int l = 0; l < 2; ++l) {
        const int pb = 1 + 11 * l;
        PH_BEGIN(pb + 0) norm_phase(l == 0 ? (const void*)pa->in[0] : (const void*)X, l == 0 ? (const void*)pa->in[2] : (const void*)XC, l == 0, l == 0, pa->in[6] + l * 3 * DM, modl, 0, 1, H, MALL,
                l == 1 ? (const float*)(ws + WS_P) : (const float*)nullptr, (const float*)(ws + WS_MOD) + 8 * NMODC + 8 * DM, 0.5f, XC, lane, wave); PH_END(pb + 0)
        PH_BEGIN(pb + 1) pg8::Gemm g{H, W + WO_GU1, MALL, 2 * DFF, DM}; pg8::StaticOrder S; S.init(MALL, 2 * DFF, G, bx); pg8::EpiSwiGLU E{(bf16*)R, DFF}; REPK(1) GEMM_PHASE(pg8::EpiSwiGLU, g, S, E); PH_END(pb + 1)
        PH_BEGIN(pb + 2) { pg8::Gemm g{(const bf16*)R, W + WO_DN1, MLAT, DM, DFF}; pg8::StaticOrder S; S.init(MLAT, DM, G, bx);
            pg8::EpiResid E{l == 0 ? (const void*)pa->in[0] : (const void*)X, l == 0 ? (const void*)pa->in[2] : (const void*)XC, l == 0 ? 1 : 0, X, XC, modl + 2 * DM, 0.5f}; GEMM_PHASE(pg8::EpiResid, g, S, E); }
            CTX_SPLITK(W + WO_DN1);
        PH_END(pb + 2)
        PH_BEGIN(pb + 3) REPK(3) norm_phase(X, l == 0 ? (const void*)pa->in[2] : (const void*)XC, false, l == 0, pa->in[6] + l * 3 * DM + DM, modl, 3, 4, H, MALL,
                (const float*)(ws + WS_P), modl + 8 * NMODC + 2 * DM, 0.5f, XC, lane, wave); PH_END(pb + 3)
        PH_BEGIN(pb + 4)
            { pg8::Gemm g{H, W + WO_IN, MALL, 1792, DM}; pg8::StaticOrder S; S.init(MALL, 1792, G, bx);
              pg8::EpiIn1 E{(bf16*)(R + R_QB), (bf16*)(R + R_KB), (bf16*)(R + R_QA), (bf16*)(R + R_KA), (bf16*)(R + R_HG), (const float*)(ws + WS_ROPE), SCL2}; GEMM_PHASE(pg8::EpiIn1, g, S, E); }
            { pg8::Gemm g{W + WO_IN + (size_t)1792 * DM, H, 512, MALL, DM}; pg8::StaticOrder S; S.init(512, MALL, G, G - 1 - bx); pg8::EpiBf16 E{(bf16*)(R + R_VT), MALL};   GEMM_PHASE(pg8::EpiBf16, g, S, E); }
        PH_END(pb + 4)
        #ifndef NO_MIX
        PH_BEGIN(pb + 5) mixer_phase<0>(pa, ldsp, l, tid, lane, wave);
        PH_END(pb + 5)
#endif
        PH_BEGIN(pb + 6)
            REPK(6)
#pragma unroll 1
            for (int br = 0; br < 3; ++br) {
                const bf16* Y = (const bf16*)(R + (br == 0 ? R_YA : (br == 1 ? R_YB : R_YC))); const int Kb = br == 2 ? 256 : 384;
                const bf16* Wb = W + (br == 0 ? WO_OA : (br == 1 ? WO_OB : WO_OC));
                { pg8::Gemm g{Y, Wb, MP, DM, Kb}; pg8::StaticOrder S; S.init(MP, DM, G, bx); pg8::EpiBf16 E{P, DM}; GEMM_PHASE(pg8::EpiBf16, g, S, E); }
                { pg8::Gemm g{H, W + WO_IN + (size_t)(2304 + 1024 * br) * DM, MP, DM, DM}; pg8::StaticOrder S; S.init(MP, DM, G, bx);
                  pg8::EpiGate E{P, (bf16*)R, pa->in[12] + l * 3072 + br * 1024, br}; GEMM_PHASE(pg8::EpiGate, g, S, E); }
            }
        PH_END(pb + 6)
        PH_BEGIN(pb + 7) pg8::Gemm g{P, W + WO_WO, MP, DM, DM}; pg8::StaticOrder S; S.init(MP, DM, G, bx); pg8::EpiResid E{X, XC, 0, X, XC, modl + 5 * DM, 1.0f}; GEMM_PHASE(pg8::EpiResid, g, S, E); PH_END(pb + 7)
        PH_BEGIN(pb + 8) norm_phase(X, XC, false, false, pa->in[6] + l * 3 * DM + 2 * DM, modl, 6, 7, H, MP, (const float*)nullptr, (const float*)nullptr, 0.f, XC, lane, wave); PH_END(pb + 8)
        PH_BEGIN(pb + 9) pg8::Gemm g{H, W + WO_GU2, MP, 2 * DFF, DM}; pg8::StaticOrder S; S.init(MP, 2 * DFF, G, bx); pg8::EpiSwiGLU E{(bf16*)R, DFF}; GEMM_PHASE(pg8::EpiSwiGLU, g, S, E); PH_END(pb + 9)
        PH_BEGIN(pb + 10) { pg8::Gemm g{(const bf16*)R, W + WO_DN2, MLAT, DM, DFF}; pg8::StaticOrder S; S.init(MLAT, DM, G, bx); pg8::EpiResid E{X, XC, 0, X, XC, modl + 8 * DM, 0.5f}; GEMM_PHASE(pg8::EpiResid, g, S, E); }
            if (l == 0) CTX_SPLITK(W + WO_DN2);
        PH_END(pb + 10)
    }
#ifdef PROBE_SYNCS
    for (int i_ = 0; i_ < 24; ++i_) grid.sync();
#endif
    { const int l = 0; PH_BEGIN(23) final_norm(X, pa->out, pa->in[23], lane, wave); } } }
#undef IN
#undef SEAM
}

#ifndef MK_MULTI
#define MK_MULTI 0
#endif
extern "C" void kernel_launch(void* const* d_in, const int* in_sizes, int n_in, void* d_out, int out_size, void* d_ws, size_t ws_size, hipStream_t stream) {
    static int grid = 0;
    if (grid == 0) {
        if (n_in != 24 || out_size != MLAT * DM || ws_size < WS_END) { fprintf(stderr, "kernel_launch: unexpected shapes (n_in %d out %d ws %zu)\n", n_in, out_size, ws_size); grid = -1; return; }
        int dev = 0, cus = 0, per_cu = 0;
        if (hipGetDevice(&dev) != hipSuccess || hipDeviceGetAttribute(&cus, hipDeviceAttributeMultiprocessorCount, dev) != hipSuccess) { grid = -1; return; }
        if (hipFuncSetAttribute((const void*)mk_fwd, hipFuncAttributeMaxDynamicSharedMemorySize, LDS_BYTES) != hipSuccess) { fprintf(stderr, "kernel_launch: hipFuncSetAttribute failed\n"); grid = -1; return; }
        if (hipOccupancyMaxActiveBlocksPerMultiprocessor(&per_cu, (const void*)mk_fwd, NTHR, LDS_BYTES) != hipSuccess || per_cu < 1) { fprintf(stderr, "kernel_launch: occupancy query says %d\n", per_cu); per_cu = 1; }
        (void)hipGetLastError();
        grid = cus * per_cu;
    }
    if (grid < 0) return;
    Args a{};
    for (int i = 0; i < 24; ++i) a.in[i] = (const float*)d_in[i];
    a.out = (float*)d_out; a.ws = (unsigned char*)d_ws;
#if MK_MULTI
    for (int p = 0; p < 24; ++p) { a.ph_lo = p; a.ph_hi = p + 1; hipLaunchKernelGGL(mk_fwd, dim3(grid), dim3(NTHR), LDS_BYTES, stream, a); }
#else
    a.ph_lo = 0; a.ph_hi = 24;
    void* args[] = {&a};
    hipError_t e = hipLaunchCooperativeKernel((const void*)mk_fwd, dim3(grid), dim3(NTHR), args, LDS_BYTES, stream);
    if (e != hipSuccess) fprintf(stderr, "cooperative launch failed: %s (grid %d)\n", hipGetErrorString(e), grid);
#endif
}
```

```cpp
#include <hip/hip_runtime.h>
#include <hip/hip_cooperative_groups.h>
#include <cstdio>
#include <cstdint>
namespace cg = cooperative_groups;
namespace pg8 {
#define PG8_LAS __attribute__((address_space(3)))
typedef unsigned short bf16_t;
typedef short bf16x8 __attribute__((ext_vector_type(8)));
typedef float f32x4 __attribute__((ext_vector_type(4)));
typedef unsigned u32x4 __attribute__((ext_vector_type(4)));
constexpr int BM = 256, BK = 64, HALF = 128, HTB = HALF * BK * 2  , STAGE_BYTES = 8 * HTB, NXCD = 8, WGM = 8;

__host__ __device__ __forceinline__ int lds_byte(int r, int c) { const int st = (r >> 4) * 2 + (c >> 5), rr = r & 15, cc = c & 31, ob = rr * 64 + cc * 2; return st * 1024 + (ob ^ (((ob >> 9) & 1) << 5)); }
__host__ __device__ __forceinline__ void stage_rc(int b, int& R, int& C) { const int st = b / 1024, sb = b % 1024, swz = sb ^ (((sb >> 9) & 1) << 5); R = (st >> 1) * 16 + swz / 64; C = (st & 1) * 32 + (swz % 64) / 2; }
__host__ __device__ __forceinline__ int perm32(int rho) { const int n = rho >> 4, i = rho & 15; return 8 * (i >> 2) + 4 * n + (i & 3); }

struct Unit { int pm, pn; };
struct Gemm { const bf16_t* A; const bf16_t* Bt; int M, N, K; int Kx; };

struct StaticOrder {
    int nM, nN, nwg, G, c;
    __host__ __device__ void init(int M, int N, int G_, int c_) { nM = M / BM; nN = N / BM; nwg = nM * nN; G = G_; c = c_; }
    __host__ __device__ bool next(int i, Unit& u) const {
        const long L = (long)i * G + c; if (L >= nwg) return false;
        int wgid = (int)L; { const int q = nwg / NXCD, r = nwg % NXCD, xcd = wgid % NXCD, off = wgid / NXCD; wgid = (xcd < r ? xcd * (q + 1) : r * (q + 1) + (xcd - r) * q) + off; }
        const int nig = WGM * nN, gid = wgid / nig, fm = gid * WGM, gsz = (nM - fm) < WGM ? (nM - fm) : WGM;
        u.pm = fm + ((wgid % nig) % gsz); u.pn = (wgid % nig) / gsz; return true;
    }
    __device__ __forceinline__ void a_ready(const Unit&) const {}
    __device__ __forceinline__ void done(const Unit&) const {}
};

__device__ __forceinline__ unsigned cvt_pk_bf16(float lo, float hi) { unsigned r; asm volatile("v_cvt_pk_bf16_f32 %0, %1, %2" : "=v"(r) : "v"(lo), "v"(hi)); return r; }
__device__ __forceinline__ float sigm(float x) { return __builtin_amdgcn_rcpf(1.f + __expf(-x)); }
__device__ __forceinline__ u32x4 pack8(const f32x4& v0, const f32x4& v1) { u32x4 w; w.x = cvt_pk_bf16(v0[0], v0[1]); w.y = cvt_pk_bf16(v0[2], v0[3]); w.z = cvt_pk_bf16(v1[0], v1[1]); w.w = cvt_pk_bf16(v1[2], v1[3]); return w; }
__device__ __forceinline__ f32x4 bflo(unsigned a, unsigned b) { f32x4 r; r[0] = __builtin_bit_cast(float, a << 16); r[1] = __builtin_bit_cast(float, a & 0xffff0000u); r[2] = __builtin_bit_cast(float, b << 16); r[3] = __builtin_bit_cast(float, b & 0xffff0000u); return r; }

struct EpiSwiGLU {
    static constexpr bool PERM = true, AFTER_DRAIN = false;
    bf16_t* O; int ldc;
    __device__ __forceinline__ void operator()(const f32x4 (&acc)[2][2][4][2], const Unit& u, int wr, int wc, int fr, int fq) const {
        const int row0 = u.pm * BM + wr * 64 + fr, col0 = u.pn * HALF + wc * 32 + 8 * fq;
#pragma unroll
        for (int ai = 0; ai < 2; ++ai)
#pragma unroll
            for (int m = 0; m < 4; ++m) {
                f32x4 v[2];
#pragma unroll
                for (int n = 0; n < 2; ++n)
#pragma unroll
                    for (int j = 0; j < 4; ++j) { const float a = acc[ai][0][m][n][j], b = acc[ai][1][m][n][j]; v[n][j] = a * sigm(a) * b; }
                *(u32x4*)(O + (size_t)(row0 + ai * HALF + m * 16) * ldc + col0) = pack8(v[0], v[1]);
            }
    }
};

struct EpiResid {
    static constexpr bool PERM = true, AFTER_DRAIN = false;
    const void* srcL; const void* srcC; int src_f32; bf16_t* dstL; bf16_t* dstC; const float* gate; float coef;
    __device__ __forceinline__ void operator()(const f32x4 (&acc)[2][2][4][2], const Unit& u, int wr, int wc, int fr, int fq) const {
        const bool lat = u.pm < 128;
        const size_t tile0 = (size_t)(lat ? u.pm : u.pm - 128) * BM * 1024;
        const void* srcv = lat ? srcL : srcC;
        bf16_t* dst = (lat ? dstL : dstC) + tile0;
        const float* g = gate + (lat ? (u.pm >> 4) : 8) * 9216;
        const int rl = wr * 64 + fr, col0 = u.pn * BM + wc * 32 + 8 * fq;
        f32x4 gv[2][2];
#pragma unroll
        for (int bj = 0; bj < 2; ++bj)
#pragma unroll
            for (int n = 0; n < 2; ++n) gv[bj][n] = *(const f32x4*)(g + col0 + bj * HALF + 4 * n) * coef;
#pragma unroll
        for (int ai = 0; ai < 2; ++ai)
#pragma unroll
            for (int m = 0; m < 4; ++m)
#pragma unroll
                for (int bj = 0; bj < 2; ++bj) {
                    const size_t off = (size_t)(rl + ai * HALF + m * 16) * 1024 + col0 + bj * HALF;
                    f32x4 x0, x1;
                    if (src_f32) { const float* sp = (const float*)srcv + tile0 + off; x0 = *(const f32x4*)sp; x1 = *(const f32x4*)(sp + 4); }
                    else { const u32x4 w = *(const u32x4*)((const bf16_t*)srcv + tile0 + off); x0 = bflo(w.x, w.y); x1 = bflo(w.z, w.w); }
                    *(u32x4*)(dst + off) = pack8(x0 + gv[bj][0] * acc[ai][bj][m][0], x1 + gv[bj][1] * acc[ai][bj][m][1]);
                }
    }
};

struct EpiIn1 {
    static constexpr bool PERM = true, AFTER_DRAIN = false;
    bf16_t *QB, *KB, *QA, *KA, *HG; const float* rope; float qs;
    __device__ __forceinline__ void operator()(const f32x4 (&acc)[2][2][4][2], const Unit& u, int wr, int wc, int fr, int fq) const {
        const int row0 = u.pm * BM + wr * 64 + fr; const bool lat = u.pm < 128; const int pn = u.pn;
        if (pn < 2) {
            const int g8 = 4 * pn + wc; bf16_t* dst = g8 < 6 ? QB + g8 * 64 : KB + (g8 - 6) * 64; const int ld = g8 < 6 ? 384 : 128; const float sc = g8 < 6 ? qs : 1.f;
#pragma unroll
            for (int ai = 0; ai < 2; ++ai)
#pragma unroll
                for (int m = 0; m < 4; ++m) {
                    const int row = row0 + ai * HALF + m * 16;
                    f32x4 y1[2], y2[2];
                    if (lat) {
                        const int t = row & 4095, pos = fq < 2 ? (t >> 6) : (t & 63); const float* rp = rope + pos * 16 + 8 * (fq & 1);
#pragma unroll
                        for (int n = 0; n < 2; ++n) { const f32x4 c = *(const f32x4*)(rp + 4 * n), s = *(const f32x4*)(rp + 1024 + 4 * n);
                            const f32x4 x1 = acc[ai][0][m][n], x2 = acc[ai][1][m][n]; y1[n] = x1 * c - x2 * s; y2[n] = x1 * s + x2 * c; }
                    } else { y1[0] = acc[ai][0][m][0]; y1[1] = acc[ai][0][m][1]; y2[0] = acc[ai][1][m][0]; y2[1] = acc[ai][1][m][1]; }
                    bf16_t* rowp = dst + (size_t)row * ld + 8 * fq;
                    *(u32x4*)(rowp) = pack8(y1[0] * sc, y1[1] * sc); *(u32x4*)(rowp + 32) = pack8(y2[0] * sc, y2[1] * sc);
                }
        } else if (pn < 5) {
#pragma unroll
            for (int bj = 0; bj < 2; ++bj) {
                const int c = (pn - 2) * BM + bj * HALF + wc * 32 + 8 * fq; bf16_t* dst = c < 384 ? QA + c : KA + (c - 384); const float sc = c < 384 ? qs : 1.f;
#pragma unroll
                for (int ai = 0; ai < 2; ++ai)
#pragma unroll
                    for (int m = 0; m < 4; ++m) *(u32x4*)(dst + (size_t)(row0 + ai * HALF + m * 16) * 384) = pack8(acc[ai][bj][m][0] * sc, acc[ai][bj][m][1] * sc);
            }
        } else {
            const int col = (pn - 5) * HALF + wc * 32 + 8 * fq;
#pragma unroll
            for (int ai = 0; ai < 2; ++ai)
#pragma unroll
                for (int m = 0; m < 4; ++m) {
                    f32x4 v[2];
#pragma unroll
                    for (int n = 0; n < 2; ++n)
#pragma unroll
                        for (int j = 0; j < 4; ++j) v[n][j] = acc[ai][0][m][n][j] * sigm(acc[ai][1][m][n][j]);
                    *(u32x4*)(HG + (size_t)(row0 + ai * HALF + m * 16) * 256 + col) = pack8(v[0], v[1]);
                }
        }
    }
};

struct EpiBf16 {
    static constexpr bool PERM = true, AFTER_DRAIN = false;
    bf16_t* O; int ldc;
    __device__ __forceinline__ void operator()(const f32x4 (&acc)[2][2][4][2], const Unit& u, int wr, int wc, int fr, int fq) const {
        const int row0 = u.pm * BM + wr * 64 + fr, col0 = u.pn * BM + wc * 32 + 8 * fq;
#pragma unroll
        for (int ai = 0; ai < 2; ++ai)
#pragma unroll
            for (int m = 0; m < 4; ++m)
#pragma unroll
                for (int bj = 0; bj < 2; ++bj) *(u32x4*)(O + (size_t)(row0 + ai * HALF + m * 16) * ldc + col0 + bj * HALF) = pack8(acc[ai][bj][m][0], acc[ai][bj][m][1]);
    }
};

struct EpiF32 {
    static constexpr bool PERM = true, AFTER_DRAIN = false;
    float* O; int ldc;
    __device__ __forceinline__ void operator()(const f32x4 (&acc)[2][2][4][2], const Unit& u, int wr, int wc, int fr, int fq) const {
        const int row0 = u.pm * BM + wr * 64 + fr, col0 = u.pn * BM + wc * 32 + 8 * fq;
#pragma unroll
        for (int ai = 0; ai < 2; ++ai)
#pragma unroll
            for (int m = 0; m < 4; ++m)
#pragma unroll
                for (int bj = 0; bj < 2; ++bj) { float* o = O + (size_t)(row0 + ai * HALF + m * 16) * ldc + col0 + bj * HALF; *(f32x4*)o = acc[ai][bj][m][0]; *(f32x4*)(o + 4) = acc[ai][bj][m][1]; }
    }
};

struct EpiGate {
    static constexpr bool PERM = true, AFTER_DRAIN = false;
    bf16_t* P; bf16_t* T; const float* bg; int br;
    __device__ __forceinline__ void operator()(const f32x4 (&acc)[2][2][4][2], const Unit& u, int wr, int wc, int fr, int fq) const {
        const int row0 = u.pm * BM + wr * 64 + fr, col0 = u.pn * BM + wc * 32 + 8 * fq;
        f32x4 bv[2][2];
#pragma unroll
        for (int bj = 0; bj < 2; ++bj)
#pragma unroll
            for (int n = 0; n < 2; ++n) bv[bj][n] = *(const f32x4*)(bg + col0 + bj * HALF + 4 * n);
#pragma unroll
        for (int ai = 0; ai < 2; ++ai)
#pragma unroll
            for (int m = 0; m < 4; ++m)
#pragma unroll
                for (int bj = 0; bj < 2; ++bj) {
                    const size_t off = (size_t)(row0 + ai * HALF + m * 16) * 1024 + col0 + bj * HALF;
                    const u32x4 pw = *(const u32x4*)(P + off);
                    const f32x4 p0 = bflo(pw.x, pw.y), p1 = bflo(pw.z, pw.w);
                    f32x4 t0, t1;
#pragma unroll
                    for (int j = 0; j < 4; ++j) { t0[j] = sigm(acc[ai][bj][m][0][j] + bv[bj][0][j]) * p0[j]; t1[j] = sigm(acc[ai][bj][m][1][j] + bv[bj][1][j]) * p1[j]; }
                    if (br != 0) { const u32x4 tw = *(const u32x4*)(T + off); t0 = t0 + bflo(tw.x, tw.y); t1 = t1 + bflo(tw.z, tw.w); }
                    *(u32x4*)((br == 2 ? P : T) + off) = pack8(t0, t1);
                }
    }
};

template <class Epi, class Sched, bool ALIGN_EPI = false, bool SP2 = false>
__device__ __forceinline__ void gemm_phase(PG8_LAS unsigned char* lds, const Gemm g, const Sched& S, const Epi& E) {
    int tid_l = threadIdx.x; asm volatile("" : "+v"(tid_l));
    const int tid = tid_l, wid = __builtin_amdgcn_readfirstlane(tid >> 6), lane = tid & 63, wr = wid >> 2, wc = wid & 3, fr = lane & 15, fq = lane >> 4;
    const int K = g.K, nt = (g.Kx ? g.Kx : K) / BK;
    unsigned voffA[2], voffB[2];
#pragma unroll
    for (int i = 0; i < 2; ++i) { int R, C; stage_rc(tid * 16 + i * 8192, R, C); const int Rb = Epi::PERM ? ((R & ~31) + perm32(R & 31)) : R;
        voffA[i] = (unsigned)(R * K + C) * 2u; voffB[i] = (unsigned)(Rb * K + C) * 2u; }
    const size_t kstep = (size_t)(BK * 2);
    const size_t hstep = (size_t)HALF * K * 2;
    const size_t tstep = 2 * hstep;
    const unsigned ldsw = (unsigned)wid * 1024u;
    const int aoff = lds_byte(wr * 64 + fr, fq * 8), boff = lds_byte(wc * 32 + fr, fq * 8);
#define PG8_SA(b, h) (((b) * 2 + (h)) * HTB)
#define PG8_SB(b, h) ((4 + (b) * 2 + (h)) * HTB)
#define PG8_STAGE(bufoff, gbase, voff) do { _Pragma("unroll") for (int _i = 0; _i < 2; ++_i) \
        __builtin_amdgcn_global_load_lds((const unsigned*)((const char*)(gbase) + (voff)[_i]), (PG8_LAS unsigned*)(lds + (bufoff) + ldsw + _i * 8192), 16, 0, 0); } while (0)
#define PG8_LDA(dst, b, h) do { _Pragma("unroll") for (int m = 0; m < 4; ++m) _Pragma("unroll") for (int k = 0; k < 2; ++k) dst[m][k] = *(const PG8_LAS bf16x8*)(lds + PG8_SA(b, h) + aoff + m * 2048 + k * 1024); } while (0)
#define PG8_LDB(dst, b, h) do { _Pragma("unroll") for (int n = 0; n < 2; ++n) _Pragma("unroll") for (int k = 0; k < 2; ++k) dst[n][k] = *(const PG8_LAS bf16x8*)(lds + PG8_SB(b, h) + boff + n * 2048 + k * 1024); } while (0)
#define PG8_MMA(ai, bj, At, Bt) do { __builtin_amdgcn_s_setprio(1); _Pragma("unroll") for (int m = 0; m < 4; ++m) _Pragma("unroll") for (int n = 0; n < 2; ++n) _Pragma("unroll") for (int k = 0; k < 2; ++k) \
        acc[ai][bj][m][n] = __builtin_amdgcn_mfma_f32_16x16x32_bf16(Bt[n][k], At[m][k], acc[ai][bj][m][n], 0, 0, 0); __builtin_amdgcn_s_setprio(0); } while (0)
#define PG8_WAIT_V(n) asm volatile("s_waitcnt vmcnt(" #n ")" ::: "memory")
#define PG8_WAIT_L(n) asm volatile("s_waitcnt lgkmcnt(" #n ")" ::: "memory")
#define PG8_BAR __builtin_amdgcn_s_barrier()
#define PG8_SCHED __builtin_amdgcn_sched_barrier(0)
    Unit cur, nxt; int ui = 0;
    if (!S.next(0, cur)) return;
    f32x4 acc[2][2][4][2];
#pragma unroll
    for (int a = 0; a < 2; ++a)
#pragma unroll
        for (int b = 0; b < 2; ++b)
#pragma unroll
            for (int m = 0; m < 4; ++m)
#pragma unroll
                for (int n = 0; n < 2; ++n) acc[a][b][m][n] = (f32x4){0.f, 0.f, 0.f, 0.f};
    bf16x8 At[4][2], B0[2][2], B1[2][2];
    const char* cA = (const char*)g.A + (size_t)cur.pm * tstep; const char* cB = (const char*)g.Bt + (size_t)cur.pn * tstep;
    S.a_ready(cur);
    if constexpr (SP2) {
        PG8_STAGE(PG8_SB(0, 0), cB, voffB); PG8_STAGE(PG8_SB(0, 1), cB + hstep, voffB); PG8_STAGE(PG8_SA(0, 0), cA, voffA); PG8_STAGE(PG8_SA(0, 1), cA + hstep, voffA);
        if (wr == 1) PG8_BAR;
        PG8_WAIT_V(2); PG8_BAR;
        PG8_STAGE(PG8_SB(1, 0), cB + kstep, voffB); PG8_STAGE(PG8_SA(1, 0), cA + kstep, voffA); PG8_STAGE(PG8_SB(1, 1), cB + hstep + kstep, voffB);
        PG8_WAIT_V(6); PG8_BAR;
    } else {
        PG8_STAGE(PG8_SB(0, 0), cB, voffB); PG8_STAGE(PG8_SA(0, 0), cA, voffA); PG8_STAGE(PG8_SB(0, 1), cB + hstep, voffB); PG8_STAGE(PG8_SA(0, 1), cA + hstep, voffA);
        if (wr == 1) PG8_BAR;
        PG8_WAIT_V(4); PG8_BAR;
        PG8_STAGE(PG8_SB(1, 0), cB + kstep, voffB); PG8_STAGE(PG8_SA(1, 0), cA + kstep, voffA); PG8_STAGE(PG8_SB(1, 1), cB + hstep + kstep, voffB);
        PG8_WAIT_V(6); PG8_BAR;
    }
    for (;;) {
        const bool has_next = S.next(ui + 1, nxt);
        const char* nA = has_next ? (const char*)g.A + (size_t)nxt.pm * tstep : cA; const char* nB = has_next ? (const char*)g.Bt + (size_t)nxt.pn * tstep : cB;
        for (int t = 0; t < nt; t += 2) {
            const bool last = (t == nt - 2);
            const char* a1 = cA + (size_t)(t + 1) * kstep;
            const char* a2 = last ? nA : cA + (size_t)(t + 2) * kstep; const char* b2 = last ? nB : cB + (size_t)(t + 2) * kstep;
            const char* a3 = a2 + kstep; const char* b3 = b2 + kstep;
            if (last && has_next) S.a_ready(nxt);
            if constexpr (SP2) {
            PG8_LDB(B0, 0, 0); PG8_LDB(B1, 0, 1); PG8_SCHED; PG8_LDA(At, 0, 0); PG8_STAGE(PG8_SA(1, 1), a1 + hstep, voffA);
            PG8_WAIT_V(8); PG8_WAIT_L(0); PG8_BAR; PG8_MMA(0, 0, At, B0); PG8_MMA(0, 1, At, B1); PG8_BAR; PG8_SCHED;
            PG8_LDA(At, 0, 1); PG8_STAGE(PG8_SB(0, 0), b2, voffB); PG8_STAGE(PG8_SB(0, 1), b2 + hstep, voffB); PG8_STAGE(PG8_SA(0, 0), a2, voffA);
            PG8_WAIT_V(8); PG8_WAIT_L(0); PG8_BAR; PG8_MMA(1, 0, At, B0); PG8_MMA(1, 1, At, B1); PG8_BAR; PG8_SCHED;
            PG8_LDB(B0, 1, 0); PG8_LDB(B1, 1, 1); PG8_SCHED; PG8_LDA(At, 1, 0); PG8_STAGE(PG8_SA(0, 1), a2 + hstep, voffA);
            PG8_WAIT_V(8); PG8_WAIT_L(0); PG8_BAR; PG8_MMA(0, 0, At, B0); PG8_MMA(0, 1, At, B1); PG8_BAR; PG8_SCHED;
            PG8_LDA(At, 1, 1); PG8_STAGE(PG8_SB(1, 0), b3, voffB); PG8_STAGE(PG8_SB(1, 1), b3 + hstep, voffB); PG8_STAGE(PG8_SA(1, 0), a3, voffA);
            PG8_WAIT_V(8); PG8_WAIT_L(0); PG8_BAR; PG8_MMA(1, 0, At, B0); PG8_MMA(1, 1, At, B1); PG8_BAR; PG8_SCHED;
            } else {
            PG8_LDB(B0, 0, 0); PG8_SCHED; PG8_LDA(At, 0, 0); PG8_STAGE(PG8_SA(1, 1), a1 + hstep, voffA);
            PG8_WAIT_L(8); PG8_BAR; PG8_WAIT_L(0); PG8_MMA(0, 0, At, B0); PG8_BAR; PG8_SCHED;
            PG8_LDB(B1, 0, 1); PG8_STAGE(PG8_SB(0, 0), b2, voffB);
            PG8_BAR; PG8_WAIT_L(0); PG8_MMA(0, 1, At, B1); PG8_BAR;
            PG8_LDA(At, 0, 1); PG8_STAGE(PG8_SA(0, 0), a2, voffA);
            PG8_BAR; PG8_WAIT_L(0); PG8_MMA(1, 0, At, B0); PG8_BAR; PG8_SCHED;
            PG8_STAGE(PG8_SB(0, 1), b2 + hstep, voffB);
            PG8_WAIT_V(6); PG8_BAR; PG8_MMA(1, 1, At, B1); PG8_BAR;
            PG8_LDB(B0, 1, 0); PG8_SCHED; PG8_LDA(At, 1, 0); PG8_STAGE(PG8_SA(0, 1), a2 + hstep, voffA);
            PG8_WAIT_L(8); PG8_BAR; PG8_WAIT_L(0); PG8_MMA(0, 0, At, B0); PG8_BAR; PG8_SCHED;
            PG8_LDB(B1, 1, 1); PG8_STAGE(PG8_SB(1, 0), b3, voffB);
            PG8_BAR; PG8_WAIT_L(0); PG8_MMA(0, 1, At, B1); PG8_BAR;
            PG8_LDA(At, 1, 1); PG8_STAGE(PG8_SA(1, 0), a3, voffA);
            PG8_BAR; PG8_WAIT_L(0); PG8_MMA(1, 0, At, B0); PG8_BAR; PG8_SCHED;
            PG8_STAGE(PG8_SB(1, 1), b3 + hstep, voffB);
            PG8_WAIT_V(6); PG8_BAR; PG8_MMA(1, 1, At, B1); PG8_BAR;
            }
        }
        if constexpr (ALIGN_EPI) { if (wr == 0) PG8_BAR; }
        if constexpr (!Epi::AFTER_DRAIN) { E(acc, cur, wr, wc, fr, fq); S.done(cur); }
        if (!has_next) break;
#pragma unroll
        for (int a = 0; a < 2; ++a)
#pragma unroll
            for (int b = 0; b < 2; ++b)
#pragma unroll
                for (int m = 0; m < 4; ++m)
#pragma unroll
                    for (int n = 0; n < 2; ++n) acc[a][b][m][n] = (f32x4){0.f, 0.f, 0.f, 0.f};
        cur = nxt; cA = nA; cB = nB; ++ui;
        if constexpr (ALIGN_EPI) { if (wr == 1) PG8_BAR; }
    }
    PG8_WAIT_V(0);
    if constexpr (!ALIGN_EPI) { if (wr == 0) PG8_BAR; }
    PG8_BAR;
    if constexpr (Epi::AFTER_DRAIN) { E.fused(acc, cur, wr, wc, fr, fq, lds, wid, lane); S.done(cur); }
#undef PG8_SA
#undef PG8_SB
#undef PG8_STAGE
#undef PG8_LDA
#undef PG8_LDB
#undef PG8_MMA
#undef PG8_WAIT_V
#undef PG8_WAIT_L
#undef PG8_BAR
#undef PG8_SCHED
}
}

#define LAS __attribute__((address_space(3)))
typedef unsigned short bf16;
typedef float f32x4 __attribute__((ext_vector_type(4)));
typedef short bf16x8 __attribute__((ext_vector_type(8)));
typedef unsigned u32x4 __attribute__((ext_vector_type(4)));
typedef unsigned u32x2 __attribute__((ext_vector_type(2)));

constexpr int DM = 1024, NB = 8, SEQ = 4096, MLAT = NB * SEQ, CTXL = 256, MCTX = NB * CTXL, MALL = MLAT + MCTX, DFF = 2816;
constexpr int NMODC = 9 * DM, IN_DIM = 5376;
constexpr float LOG2E = 1.4426950408889634f, SCL2 = 0.125f * LOG2E, NEGB = -1e30f, RMS_EPS = 1e-6f;
constexpr int NWAVES = 8, NTHR = 512;
constexpr int LDS_BYTES = 147456, LDS_ST = 147456 - 64;

constexpr size_t MiB = 1u << 20;
constexpr size_t WS_MOD = 0, WS_ROPE = 1 * MiB, WS_CTR = 1 * MiB + 65536, WS_BAR = 1 * MiB + 131072, WS_XC = 2 * MiB, WS_H = 10 * MiB, WS_R = 78 * MiB, WS_P = 282 * MiB, WS_W = 350 * MiB, WS_XB = 445 * MiB, WS_END = 509 * MiB;
constexpr size_t R_QB = 0, R_KB = R_QB + (size_t)MALL * 384 * 2, R_QA = R_KB + (size_t)MALL * 128 * 2, R_KA = R_QA + (size_t)MALL * 384 * 2, R_HG = R_KA + (size_t)MALL * 384 * 2,
                 R_VT = R_HG + (size_t)MALL * 256 * 2, R_YA = R_VT + (size_t)MALL * 512 * 2, R_YB = R_YA + (size_t)MALL * 384 * 2, R_YC = R_YB + (size_t)MALL * 384 * 2, R_END = R_YC + (size_t)MALL * 256 * 2;
static_assert(R_YA == (size_t)MALL * 1024 * 4 && R_END <= 204 * MiB && (size_t)MALL * DFF * 2 <= 204 * MiB, "region map");
constexpr size_t WO_GU1 = 0, WO_DN1 = 5767168, WO_GU2 = 8650752, WO_DN2 = 14417920, WO_IN = 17301504, WO_OA = 22806528, WO_OB = 23199744, WO_OC = 23592960, WO_WO = 23855104, WL_ELEMS = 24903680;
static_assert(WS_W + 2 * WL_ELEMS * 2 <= WS_XB && WS_XB + (size_t)MLAT * DM * 2 <= WS_END, "weights / residual map");

struct Args { const float* in[24]; float* out; unsigned char* ws; int ph_lo, ph_hi; };
typedef const __attribute__((address_space(4))) Args* KArgs;
__device__ __forceinline__ KArgs kargs() { KArgs p = (KArgs)__builtin_amdgcn_kernarg_segment_ptr(); asm volatile("" : "+s"(p)); return p; }

__device__ __forceinline__ float wave_sum(float v) {
#pragma unroll
    for (int o = 1; o < 64; o <<= 1) v += __shfl_xor(v, o);
    return v;
}
__device__ __forceinline__ unsigned pk2(float lo, float hi) { return pg8::cvt_pk_bf16(lo, hi); }
__device__ __forceinline__ float silu_f(float x) { return x * __builtin_amdgcn_rcpf(1.f + __expf(-x)); }
__device__ __forceinline__ float ex2(float x) { return __builtin_amdgcn_exp2f(x); }

__device__ __forceinline__ int gu_row(int n0) { const int h = n0 >= DFF, r = n0 - h * DFF; return 256 * (r >> 7) + 128 * h + (r & 127); }
__device__ __forceinline__ int in_row(int n0) {
    if (n0 < 768) return 512 + n0;
    if (n0 < 1152) return 1792 + (n0 - 768);
    if (n0 < 1664) { const int s = n0 - 1152, g8 = s >> 6, hf = (s >> 5) & 1; return 256 * (g8 >> 2) + 128 * hf + 32 * (g8 & 3); }
    if (n0 < 1792) return 1792 + 384 + (n0 - 1664);
    if (n0 < 2304) { const int s = n0 - 1792, hf = s >> 8, r = s & 255; return 1280 + 256 * (r >> 7) + 128 * hf + (r & 127); }
    return n0;
}
__device__ __forceinline__ void transpose_item(const float* W, int K, int N, bf16* WT, int k0, int n0, int drow0, LAS float* scr, int lane) {
#pragma unroll 8
    for (int i = 0; i < 32; ++i) { const int kk = 2 * i + (lane >> 5); scr[kk * 33 + (lane & 31)] = W[(size_t)(k0 + kk) * N + n0 + (lane & 31)]; }
    asm volatile("s_waitcnt lgkmcnt(0)" ::: "memory");
    const int c = lane & 7;
#pragma unroll
    for (int j = 0; j < 4; ++j) { const int n = (lane >> 3) + 8 * j; const LAS float* s = scr + (8 * c) * 33 + n;
        u32x4 o; o.x = pk2(s[0 * 33], s[1 * 33]); o.y = pk2(s[2 * 33], s[3 * 33]); o.z = pk2(s[4 * 33], s[5 * 33]); o.w = pk2(s[6 * 33], s[7 * 33]);
        *(u32x4*)(WT + (size_t)(drow0 + n) * K + k0 + 8 * c) = o; }
    asm volatile("s_waitcnt lgkmcnt(0)" ::: "memory");
}

__device__ __forceinline__ void prologue(KArgs pa, LAS unsigned char* lds, int tid, int lane, int wave) {
    const int G = gridDim.x, bx = blockIdx.x;
    float* modv = (float*)(pa->ws + WS_MOD);
    if (bx == 0) { float* rt = (float*)(pa->ws + WS_ROPE);
        if (tid < 36) __hip_atomic_store((unsigned*)(pa->ws + WS_CTR) + 64 * tid, 0u, __ATOMIC_RELAXED, __HIP_MEMORY_SCOPE_AGENT);
        for (int i = tid; i < 3456  ; i += NTHR) __hip_atomic_store((unsigned*)(pa->ws + WS_BAR) + i, 0u, __ATOMIC_RELAXED, __HIP_MEMORY_SCOPE_AGENT);
        for (int i = tid; i < 1024; i += NTHR) { const int pos = i >> 4, f = i & 15; const float inv = exp2f(-(float)f * (13.287712379549449f / 16.f)); const float ang = (float)pos * inv;
            rt[i] = cosf(ang); rt[1024 + i] = sinf(ang); } }
    if (bx < 288) {
        LAS float* sc = (LAS float*)lds; LAS float* part = (LAS float*)(lds + 36864);
        for (int i = tid; i < 9 * DM; i += NTHR) { const int row = i >> 10, k = i & 1023; const float v = row < 8 ? pa->in[1][row * DM + k] : pa->in[3][k]; sc[i] = silu_f(v); }
        __syncthreads();
        for (int unit = bx; unit < 288; unit += G) {
            const int l = unit / 144, cg64 = unit % 144, col = cg64 * 64 + lane;
            const float* w = pa->in[4] + (size_t)l * DM * NMODC + col;
            float acc[9];
#pragma unroll
            for (int r = 0; r < 9; ++r) acc[r] = 0.f;
            for (int k = wave * 128; k < wave * 128 + 128; k += 4) {
                const float w0 = w[(size_t)k * NMODC], w1 = w[(size_t)(k + 1) * NMODC], w2 = w[(size_t)(k + 2) * NMODC], w3 = w[(size_t)(k + 3) * NMODC];
#pragma unroll
                for (int r = 0; r < 9; ++r) { const f32x4 s = *(const LAS f32x4*)(sc + r * DM + k); acc[r] += s[0] * w0 + s[1] * w1 + s[2] * w2 + s[3] * w3; }
            }
#pragma unroll
            for (int r = 0; r < 9; ++r) part[(wave * 9 + r) * 64 + lane] = acc[r];
            __syncthreads();
            for (int i = tid; i < 576; i += NTHR) { const int r = i >> 6, cl = i & 63; float s = 0.f;
#pragma unroll
                for (int w8 = 0; w8 < 8; ++w8) s += part[(w8 * 9 + r) * 64 + cl];
                modv[((size_t)l * 9 + r) * NMODC + cg64 * 64 + cl] = s + pa->in[5][l * NMODC + cg64 * 64 + cl]; }
            __syncthreads();
        }
    }
    LAS float* scr = (LAS float*)(lds + 65536 + wave * 8704);
    const int gw = bx * NWAVES + wave, NGW = G * NWAVES;
    constexpr int I_GU = 16 * 176, I_DN = 44 * 32, I_IN = 16 * 168, I_OA = 6 * 32, I_OC = 4 * 32, I_WO = 16 * 32, I_L = 2 * I_GU + 2 * I_DN + I_IN + 2 * I_OA + I_OC + I_WO;
    for (int it = gw; it < 2 * I_L; it += NGW) {
        const int l = it / I_L; int r = it - l * I_L;
        bf16* wl = (bf16*)(pa->ws + WS_W) + (size_t)l * WL_ELEMS;
        if (r < 2 * (I_GU + I_DN)) {
            const int f = r / (I_GU + I_DN); r -= f * (I_GU + I_DN);
            if (r < I_GU) { const int kb = r / 176, nb = r % 176; transpose_item(pa->in[7 + 2 * f] + (size_t)l * DM * 2 * DFF, DM, 2 * DFF, wl + (f ? WO_GU2 : WO_GU1), 64 * kb, 32 * nb, gu_row(32 * nb), scr, lane); }
            else { r -= I_GU; const int kb = r / 32, nb = r % 32; transpose_item(pa->in[8 + 2 * f] + (size_t)l * DFF * DM, DFF, DM, wl + (f ? WO_DN2 : WO_DN1), 64 * kb, 32 * nb, 32 * nb, scr, lane); }
            continue;
        }
        r -= 2 * (I_GU + I_DN);
        if (r < I_IN) { const int kb = r / 168, nb = r % 168; transpose_item(pa->in[11] + (size_t)l * DM * IN_DIM, DM, IN_DIM, wl + WO_IN, 64 * kb, 32 * nb, in_row(32 * nb), scr, lane); continue; }
        r -= I_IN;
        if (r < I_OA) { const int kb = r / 32, nb = r % 32; transpose_item(pa->in[19] + (size_t)l * 384 * DM, 384, DM, wl + WO_OA, 64 * kb, 32 * nb, 32 * nb, scr, lane); continue; }
        r -= I_OA;
        if (r < I_OA) { const int kb = r / 32, nb = r % 32; transpose_item(pa->in[20] + (size_t)l * 384 * DM, 384, DM, wl + WO_OB, 64 * kb, 32 * nb, 32 * nb, scr, lane); continue; }
        r -= I_OA;
        if (r < I_OC) { const int kb = r / 32, nb = r % 32; transpose_item(pa->in[21] + (size_t)l * 256 * DM, 256, DM, wl + WO_OC, 64 * kb, 32 * nb, 32 * nb, scr, lane); continue; }
        r -= I_OC;
        { const int kb = r / 32, nb = r % 32; transpose_item(pa->in[22] + (size_t)l * DM * DM, DM, DM, wl + WO_WO, 64 * kb, 32 * nb, 32 * nb, scr, lane); }
    }
}

__device__ __forceinline__ void row_load(f32x4 (&v)[4], const void* base, size_t row, bool f32src, int lane) {
    if (f32src) {
#pragma unroll
        for (int j = 0; j < 4; ++j) v[j] = *((const f32x4*)((const float*)base + row * DM) + lane + 64 * j);
    } else {
#pragma unroll
        for (int j = 0; j < 4; ++j) { const u32x2 w = *((const u32x2*)((const bf16*)base + row * DM) + lane + 64 * j); v[j] = pg8::bflo(w.x, w.y); }
    }
}
__device__ __forceinline__ void ctx_reduce(f32x4 (&v)[4], int rc, const float* part, const float* pgate, float coef, bf16* xc_out, int lane) {
#pragma unroll
    for (int j = 0; j < 4; ++j) {
        f32x4 s = *((const f32x4*)(part + (size_t)rc * DM) + lane + 64 * j);
#pragma unroll
        for (int sl = 1; sl < 4; ++sl) s = s + *((const f32x4*)(part + ((size_t)sl * MCTX + rc) * DM) + lane + 64 * j);
        v[j] = v[j] + *((const f32x4*)pgate + lane + 64 * j) * coef * s;
        ((unsigned long long*)(xc_out + (size_t)rc * DM))[lane + 64 * j] = (unsigned long long)pk2(v[j][0], v[j][1]) | ((unsigned long long)pk2(v[j][2], v[j][3]) << 32);
    }
}
__device__ __forceinline__ void norm_phase(const void* xl, const void* xc, bool f32src, bool f32ctx, const float* g, const float* modl, int shift_q, int scale_q, bf16* H, int nrows,
                                           const float* part, const float* pgate, float coef, bf16* xc_out, int lane, int wave) {
    const int gw = blockIdx.x * NWAVES + wave, NGW = gridDim.x * NWAVES;
    f32x4 gv[4];
#pragma unroll
    for (int j = 0; j < 4; ++j) gv[j] = *((const f32x4*)g + lane + 64 * j);
    for (int r0 = gw; r0 < nrows; r0 += 2 * NGW) {
        const int r1 = r0 + NGW; const bool has1 = r1 < nrows; const int r1c = has1 ? r1 : r0;
        f32x4 v0[4], v1[4]; float s0 = 0.f, s1 = 0.f;
        row_load(v0, r0 < MLAT ? xl : xc, (size_t)(r0 < MLAT ? r0 : r0 - MLAT), r0 < MLAT ? f32src : f32ctx, lane);
        row_load(v1, r1c < MLAT ? xl : xc, (size_t)(r1c < MLAT ? r1c : r1c - MLAT), r1c < MLAT ? f32src : f32ctx, lane);
        if (part && r0 >= MLAT) ctx_reduce(v0, r0 - MLAT, part, pgate, coef, xc_out, lane);
        if (part && has1 && r1 >= MLAT) ctx_reduce(v1, r1 - MLAT, part, pgate, coef, xc_out, lane);
#pragma unroll
        for (int j = 0; j < 4; ++j) { s0 += (v0[j][0] * v0[j][0] + v0[j][1] * v0[j][1]) + (v0[j][2] * v0[j][2] + v0[j][3] * v0[j][3]); s1 += (v1[j][0] * v1[j][0] + v1[j][1] * v1[j][1]) + (v1[j][2] * v1[j][2] + v1[j][3] * v1[j][3]); }
        const float rstd0 = 1.f / sqrtf(wave_sum(s0) * (1.f / DM) + RMS_EPS), rstd1 = 1.f / sqrtf(wave_sum(s1) * (1.f / DM) + RMS_EPS);
        const float* mv0 = modl + (r0 < MLAT ? (r0 >> 12) : 8) * NMODC; const float* mv1 = modl + (r1c < MLAT ? (r1c >> 12) : 8) * NMODC;
        unsigned long long* o0 = (unsigned long long*)(H + (size_t)r0 * DM) + lane; unsigned long long* o1 = (unsigned long long*)(H + (size_t)r1c * DM) + lane;
#pragma unroll
        for (int j = 0; j < 4; ++j) {
            const f32x4 sh0 = *((const f32x4*)(mv0 + shift_q * DM) + lane + 64 * j), sc0 = *((const f32x4*)(mv0 + scale_q * DM) + lane + 64 * j);
            const f32x4 y0 = v0[j] * rstd0 * gv[j] * (sc0 + 1.f) + sh0;
            o0[64 * j] = (unsigned long long)pk2(y0[0], y0[1]) | ((unsigned long long)pk2(y0[2], y0[3]) << 32);
            if (has1) {
                const f32x4 sh1 = *((const f32x4*)(mv1 + shift_q * DM) + lane + 64 * j), sc1 = *((const f32x4*)(mv1 + scale_q * DM) + lane + 64 * j);
                const f32x4 y1 = v1[j] * rstd1 * gv[j] * (sc1 + 1.f) + sh1;
                o1[64 * j] = (unsigned long long)pk2(y1[0], y1[1]) | ((unsigned long long)pk2(y1[2], y1[3]) << 32);
            }
        }
    }
}
__device__ __forceinline__ void final_norm(const bf16* x, float* out, const float* g, int lane, int wave) {
    const int gw = blockIdx.x * NWAVES + wave, NGW = gridDim.x * NWAVES;
    f32x4 gv[4];
#pragma unroll
    for (int j = 0; j < 4; ++j) gv[j] = *((const f32x4*)g + lane + 64 * j);
    for (int r = gw; r < MLAT; r += NGW) {
        f32x4 v[4]; float s = 0.f;
        row_load(v, x, (size_t)r, false, lane);
#pragma unroll
        for (int j = 0; j < 4; ++j) s += (v[j][0] * v[j][0] + v[j][1] * v[j][1]) + (v[j][2] * v[j][2] + v[j][3] * v[j][3]);
        const float rstd = 1.f / sqrtf(wave_sum(s) * (1.f / DM) + RMS_EPS);
        f32x4* orow = (f32x4*)(out + (size_t)r * DM) + lane;
#pragma unroll
        for (int j = 0; j < 4; ++j) orow[64 * j] = v[j] * rstd * gv[j];
    }
}

#define MFMA16(a, b, c) __builtin_amdgcn_mfma_f32_16x16x32_bf16((a), (b), (c), 0, 0, 0)
#define AINL __attribute__((always_inline))
template <int NQ> struct AQ { bf16x8 qf[NQ][2]; float m[NQ], l[NQ]; f32x4 o[NQ][4]; };
struct KF { bf16x8 ka[2], kb[2]; };
struct VF { bf16x8 v[4]; };
__device__ __forceinline__ void k_load(KF& d, const bf16* kpa, const bf16* kpb) {
    d.ka[0] = *(const bf16x8*)kpa; d.ka[1] = *(const bf16x8*)(kpa + 32); d.kb[0] = *(const bf16x8*)kpb; d.kb[1] = *(const bf16x8*)(kpb + 32);
}
__device__ __forceinline__ void v_load(VF& d, const bf16* va, const bf16* vb) {
#pragma unroll
    for (int nb = 0; nb < 4; ++nb) { const u32x2 x = *(const u32x2*)(va + (size_t)nb * 16 * MALL), y = *(const u32x2*)(vb + (size_t)nb * 16 * MALL);
        u32x4 vw; vw.x = x.x; vw.y = x.y; vw.z = y.x; vw.w = y.y; d.v[nb] = __builtin_bit_cast(bf16x8, vw); }
}
template <int NQ> __device__ __forceinline__ void aq_init(AQ<NQ>& A) {
#pragma unroll
    for (int q = 0; q < NQ; ++q) { A.m[q] = NEGB; A.l[q] = 0.f;
#pragma unroll
        for (int nb = 0; nb < 4; ++nb) A.o[q][nb] = (f32x4){0.f, 0.f, 0.f, 0.f}; }
}
template <int NQ, class G, class F> __device__ __forceinline__ void pair_compute(AQ<NQ>& A, const KF& c, const VF& cv, G&& act, F&& f) {
    bf16x8 pf[NQ];
#pragma unroll
    for (int q = 0; q < NQ; ++q) {
        if (!act(q)) continue;
        f32x4 sa = {0.f, 0.f, 0.f, 0.f}, sb = {0.f, 0.f, 0.f, 0.f};
        sa = MFMA16(c.ka[0], A.qf[q][0], sa); sa = MFMA16(c.ka[1], A.qf[q][1], sa);
        sb = MFMA16(c.kb[0], A.qf[q][0], sb); sb = MFMA16(c.kb[1], A.qf[q][1], sb);
        f(q, sa, sb);
        float mx = fmaxf(fmaxf(fmaxf(sa[0], sa[1]), fmaxf(sa[2], sa[3])), fmaxf(fmaxf(sb[0], sb[1]), fmaxf(sb[2], sb[3])));
        mx = fmaxf(mx, __shfl_xor(mx, 16)); mx = fmaxf(mx, __shfl_xor(mx, 32));
        const float mn = fmaxf(A.m[q], mx), sc = ex2(A.m[q] - mn);
        A.m[q] = mn;
#pragma unroll
        for (int nb = 0; nb < 4; ++nb) A.o[q][nb] = A.o[q][nb] * sc;
#pragma unroll
        for (int i = 0; i < 4; ++i) { sa[i] = ex2(sa[i] - mn); sb[i] = ex2(sb[i] - mn); }
        A.l[q] = A.l[q] * sc + ((sa[0] + sa[1]) + (sa[2] + sa[3])) + ((sb[0] + sb[1]) + (sb[2] + sb[3]));
        u32x4 pw; pw.x = pk2(sa[0], sa[1]); pw.y = pk2(sa[2], sa[3]); pw.z = pk2(sb[0], sb[1]); pw.w = pk2(sb[2], sb[3]);
        pf[q] = __builtin_bit_cast(bf16x8, pw);
    }
#pragma unroll
    for (int q = 0; q < NQ; ++q) {
        if (!act(q)) continue;
#pragma unroll
        for (int nb = 0; nb < 4; ++nb) A.o[q][nb] = MFMA16(cv.v[nb], pf[q], A.o[q][nb]);
    }
}
template <class LD, class ST> __device__ __forceinline__ void pingpong(int n, LD&& ld, ST&& st) {
    KF k0, k1;
    ld(k0, 0);
    int t = 0;
#pragma unroll 1
    for (; t + 1 < n; t += 2) {
        ld(k1, t + 1);
        st(k0, t);
        ld(k0, min(t + 2, n - 1));
        st(k1, t + 1);
    }
    if (t < n) st(k0, t);
}
template <int NQ> __device__ __forceinline__ void ctx_chunk(AQ<NQ>& A, const bf16* kp, int ldk, const bf16* vp) {
    pingpong(8,
        [&](KF& kf, int t) AINL { k_load(kf, kp + (size_t)(32 * t) * ldk, kp + (size_t)(32 * t + 16) * ldk); },
        [&](const KF& kf, int t) AINL { VF vf; v_load(vf, vp + 32 * t, vp + 32 * t + 16); pair_compute<NQ>(A, kf, vf, [](int) AINL { return true; }, [](int, f32x4&, f32x4&) AINL {}); });
}
__device__ __forceinline__ void attn_store1(const f32x4 (&o)[4], float l, bf16* yp  ) {
    l += __shfl_xor(l, 16); l += __shfl_xor(l, 32);
    const float inv = 1.f / l;
#pragma unroll
    for (int nb = 0; nb < 4; ++nb) { u32x2 w; w.x = pk2(o[nb][0] * inv, o[nb][1] * inv); w.y = pk2(o[nb][2] * inv, o[nb][3] * inv); *(u32x2*)(yp + 16 * nb) = w; }
}
template <int NQ> __device__ __forceinline__ void sink_fold(AQ<NQ>& A, const float* sink, int h0, int fq) {
#pragma unroll
    for (int q = 0; q < NQ; ++q) { const float sk = sink[h0 + q] * LOG2E, mn = fmaxf(A.m[q], sk), sc = ex2(A.m[q] - mn); A.l[q] *= sc;
#pragma unroll
        for (int nb = 0; nb < 4; ++nb) A.o[q][nb] = A.o[q][nb] * sc;
        if (fq == 0) A.l[q] += ex2(sk - mn); }
}

struct AttnBufs { const bf16 *QA, *KA, *QB, *KB, *VT; bf16 *YA, *YB; };

__device__ __forceinline__ void na_unit(const AttnBufs& T, const LAS float* btab, int b, int h, int j, int rp, int fr, int fq) {
    const int hoff = h * 64, r0 = 2 * rp;
    AQ<2> A; aq_init<2>(A);
#pragma unroll
    for (int q = 0; q < 2; ++q) { const bf16* qp = T.QA + (size_t)(b * SEQ + (r0 + q) * 64 + 16 * j + fr) * 384 + hoff + 8 * fq; A.qf[q][0] = *(const bf16x8*)qp; A.qf[q][1] = *(const bf16x8*)(qp + 32); }
    const int ka0 = min(max(r0 - 4, 0), 56), kb0 = min(max(r0 - 3, 0), 56), nrow = kb0 - ka0 + 8, c0 = min(max(16 * j - 8, 0), 32);
    const int c = 16 * j + fr, w0 = min(max(c - 8, 0), 48);
    int dxo[8];
#pragma unroll
    for (int e = 0; e < 8; ++e) { const int kc = c0 + 16 * (e >> 2) + 4 * fq + (e & 3); const bool in = (kc >= w0) && (kc < w0 + 16); dxo[e] = in ? min(max(kc - c + 15, 0), 30) : 31; }
    {
        const int tk0 = b * SEQ + ka0 * 64 + c0;
        const bf16* kp = T.KA + (size_t)(tk0 + fr) * 384 + hoff + 8 * fq;
        const bf16* vp = T.VT + (size_t)(hoff + fr) * MALL + tk0 + 4 * fq;
        const LAS float* bh = btab + h * (15 * 32);
        pingpong(nrow,
            [&](KF& kf, int t) AINL { k_load(kf, kp + (size_t)(t * 64) * 384, kp + (size_t)(t * 64 + 16) * 384); },
            [&](const KF& kf, int t) AINL {
            VF vf; v_load(vf, vp + t * 64, vp + t * 64 + 16);
            const int ky = ka0 + t;
            pair_compute<2>(A, kf, vf,
                [&](int q) AINL { const int k0 = q ? kb0 : ka0; return (ky >= k0) && (ky < k0 + 8); },
                [&](int q, f32x4& sa, f32x4& sb) AINL {
                    const LAS float* rp_ = bh + (ky - (r0 + q) + 7) * 32;
#pragma unroll
                    for (int i = 0; i < 4; ++i) { sa[i] += rp_[dxo[i]]; sb[i] += rp_[dxo[4 + i]]; } }); });
    }
    ctx_chunk<2>(A, T.KA + (size_t)(MLAT + b * CTXL + fr) * 384 + hoff + 8 * fq, 384, T.VT + (size_t)(hoff + fr) * MALL + MLAT + b * CTXL + 4 * fq);
#pragma unroll
    for (int q = 0; q < 2; ++q) attn_store1(A.o[q], A.l[q], T.YA + (size_t)(b * SEQ + (r0 + q) * 64 + 16 * j + fr) * 384 + hoff + 4 * fq);
}
__device__ __forceinline__ void sw_unit(const AttnBufs& T, const float* sink, int b, int kvh, int qb, int fr, int fq) {
    const int q0 = 16 * qb, tq0 = b * SEQ + q0, khoff = kvh * 64, h0 = 3 * kvh;
    AQ<3> A; aq_init<3>(A);
#pragma unroll
    for (int q = 0; q < 3; ++q) { const bf16* qp = T.QB + (size_t)(tq0 + fr) * 384 + (h0 + q) * 64 + 8 * fq; A.qf[q][0] = *(const bf16x8*)qp; A.qf[q][1] = *(const bf16x8*)(qp + 32); }
    {
        const int tq = q0 + fr;
        const bool edge = (q0 < 128) || (q0 + 160 > SEQ);
        const bf16* kbase = T.KB + (size_t)(b * SEQ) * 128 + khoff + 8 * fq;
        const bf16* vrow = T.VT + (size_t)(384 + khoff + fr) * MALL + b * SEQ;
#define SW_KLOAD(dst, t) do { const int ka_ = q0 - 128 + 32 * (t); \
            k_load(dst, kbase + (size_t)min(max(ka_ + fr, 0), SEQ - 1) * 128, kbase + (size_t)min(max(ka_ + 16 + fr, 0), SEQ - 1) * 128); } while (0)
#define SW_VLOAD(dst, t) do { const int ka_ = q0 - 128 + 32 * (t); \
            v_load(dst, vrow + min(max(ka_ + 4 * fq, 0), SEQ - 4), vrow + min(max(ka_ + 16 + 4 * fq, 0), SEQ - 4)); } while (0)
        pingpong(9,
            [&](KF& kf, int t) AINL { SW_KLOAD(kf, t); },
            [&](const KF& kf, int t) AINL {
            VF vf; SW_VLOAD(vf, t);
            const int kt0 = q0 - 128 + 32 * t;
            const bool need = edge || (t == 0) || (t == 8);
            pair_compute<3>(A, kf, vf, [](int) AINL { return true; }, [&](int, f32x4& sa, f32x4& sb) AINL {
                if (need) {
#pragma unroll
                    for (int i = 0; i < 4; ++i) {
                        { const int tk = kt0 + 4 * fq + i, d = tq - tk; const bool ok = (d <= 128) && (d >= -128) && (tk >= 0) && (tk < SEQ); sa[i] = ok ? sa[i] : NEGB; }
                        { const int tk = kt0 + 16 + 4 * fq + i, d = tq - tk; const bool ok = (d <= 128) && (d >= -128) && (tk >= 0) && (tk < SEQ); sb[i] = ok ? sb[i] : NEGB; }
                    } } }); });
#undef SW_KLOAD
#undef SW_VLOAD
    }
    ctx_chunk<3>(A, T.KB + (size_t)(MLAT + b * CTXL + fr) * 128 + khoff + 8 * fq, 128, T.VT + (size_t)(384 + khoff + fr) * MALL + MLAT + b * CTXL + 4 * fq);
    sink_fold<3>(A, sink, h0, fq);
#pragma unroll
    for (int q = 0; q < 3; ++q) attn_store1(A.o[q], A.l[q], T.YB + (size_t)(tq0 + fr) * 384 + (h0 + q) * 64 + 4 * fq);
}
__device__ __forceinline__ void ctxa_unit(const AttnBufs& T, int b, int h, int qb, int fr, int fq) {
    const int tq0 = MLAT + b * CTXL + 16 * qb, hoff = h * 64;
    AQ<1> A; aq_init<1>(A);
    { const bf16* qp = T.QA + (size_t)(tq0 + fr) * 384 + hoff + 8 * fq; A.qf[0][0] = *(const bf16x8*)qp; A.qf[0][1] = *(const bf16x8*)(qp + 32); }
    ctx_chunk<1>(A, T.KA + (size_t)(MLAT + b * CTXL + fr) * 384 + hoff + 8 * fq, 384, T.VT + (size_t)(hoff + fr) * MALL + MLAT + b * CTXL + 4 * fq);
    attn_store1(A.o[0], A.l[0], T.YA + (size_t)(tq0 + fr) * 384 + hoff + 4 * fq);
}
__device__ __forceinline__ void ctxb_unit(const AttnBufs& T, const float* sink, int b, int kvh, int qb, int fr, int fq) {
    const int tq0 = MLAT + b * CTXL + 16 * qb, khoff = kvh * 64, h0 = 3 * kvh;
    AQ<3> A; aq_init<3>(A);
#pragma unroll
    for (int q = 0; q < 3; ++q) { const bf16* qp = T.QB + (size_t)(tq0 + fr) * 384 + (h0 + q) * 64 + 8 * fq; A.qf[q][0] = *(const bf16x8*)qp; A.qf[q][1] = *(const bf16x8*)(qp + 32); }
    ctx_chunk<3>(A, T.KB + (size_t)(MLAT + b * CTXL + fr) * 128 + khoff + 8 * fq, 128, T.VT + (size_t)(384 + khoff + fr) * MALL + MLAT + b * CTXL + 4 * fq);
    sink_fold<3>(A, sink, h0, fq);
#pragma unroll
    for (int q = 0; q < 3; ++q) attn_store1(A.o[q], A.l[q], T.YB + (size_t)(tq0 + fr) * 384 + (h0 + q) * 64 + 4 * fq);
}
constexpr int LWL = 0, LBT = 64512, LK = 76800, SROW = 144, SBUF = 64 * SROW, LBU = LK + 6 * SBUF;
struct Stage { u32x4 k, v; };
__device__ __forceinline__ void stage_load(Stage& s, const bf16* kg, const bf16* vg) { s.k = *(const u32x4*)kg; s.v = *(const u32x4*)vg; }
__device__ __forceinline__ void stage_write(LAS unsigned char* buf, const Stage& s, int tid) { const int o = (tid >> 3) * SROW + (tid & 7) * 16; *(LAS u32x4*)(buf + o) = s.k; *(LAS u32x4*)(buf + SBUF + o) = s.v; }
__device__ __forceinline__ void lds_kf(KF& d, const LAS unsigned char* kb, int tokoff, int fr, int fq) {
    const LAS unsigned char* p = kb + (tokoff + fr) * SROW + fq * 16;
    d.ka[0] = *(const LAS bf16x8*)p; d.ka[1] = *(const LAS bf16x8*)(p + 64); d.kb[0] = *(const LAS bf16x8*)(p + 16 * SROW); d.kb[1] = *(const LAS bf16x8*)(p + 16 * SROW + 64);
}
__device__ __forceinline__ void lds_vf(VF& d, const LAS unsigned char* vb, int tokoff, int fr, int fq) {
#pragma unroll
    for (int nb = 0; nb < 4; ++nb) { const LAS unsigned char* p = vb + (fr + 16 * nb) * SROW + (tokoff + 4 * fq) * 2; const u32x2 x = *(const LAS u32x2*)p, y = *(const LAS u32x2*)(p + 32);
        u32x4 vw; vw.x = x.x; vw.y = x.y; vw.z = y.x; vw.w = y.y; d.v[nb] = __builtin_bit_cast(bf16x8, vw); }
}
template <int NQ, class F> __device__ __forceinline__ void set_step(AQ<NQ>& A, const int q, const KF& c, const VF& cv, F&& f) {
    f32x4 sa = {0.f, 0.f, 0.f, 0.f}, sb = {0.f, 0.f, 0.f, 0.f};
    sa = MFMA16(c.ka[0], A.qf[q][0], sa); sa = MFMA16(c.ka[1], A.qf[q][1], sa);
    sb = MFMA16(c.kb[0], A.qf[q][0], sb); sb = MFMA16(c.kb[1], A.qf[q][1], sb);
    f(sa, sb);
    float mx = fmaxf(fmaxf(fmaxf(sa[0], sa[1]), fmaxf(sa[2], sa[3])), fmaxf(fmaxf(sb[0], sb[1]), fmaxf(sb[2], sb[3])));
    mx = fmaxf(mx, __shfl_xor(mx, 16)); mx = fmaxf(mx, __shfl_xor(mx, 32));
    const float mn = fmaxf(A.m[q], mx), sc = ex2(A.m[q] - mn);
    A.m[q] = mn;
#pragma unroll
    for (int nb = 0; nb < 4; ++nb) A.o[q][nb] = A.o[q][nb] * sc;
#pragma unroll
    for (int i = 0; i < 4; ++i) { sa[i] = ex2(sa[i] - mn); sb[i] = ex2(sb[i] - mn); }
    A.l[q] = A.l[q] * sc + ((sa[0] + sa[1]) + (sa[2] + sa[3])) + ((sb[0] + sb[1]) + (sb[2] + sb[3]));
    u32x4 pw; pw.x = pk2(sa[0], sa[1]); pw.y = pk2(sa[2], sa[3]); pw.z = pk2(sb[0], sb[1]); pw.w = pk2(sb[2], sb[3]);
    const bf16x8 pf = __builtin_bit_cast(bf16x8, pw);
#pragma unroll
    for (int nb = 0; nb < 4; ++nb) A.o[q][nb] = MFMA16(cv.v[nb], pf, A.o[q][nb]);
}
template <class SRC, class CMP> __device__ __forceinline__ void chunk_pipeline(LAS unsigned char* lds, int n, int tid, SRC&& src, CMP&& cmp) {
    Stage sA, sB; const bf16* kg; const bf16* vg;
    { Stage s0; src(0, kg, vg); stage_load(s0, kg, vg);
      if (n > 1) { src(1, kg, vg); stage_load(sA, kg, vg); }
      if (n > 2) { src(2, kg, vg); stage_load(sB, kg, vg); }
      stage_write(lds + LK, s0, tid); }
    __syncthreads();
    int i = 0, bi = 0;
#pragma unroll 1
    for (;;) {
        { LAS unsigned char* cur = lds + LK + bi * 2 * SBUF; const int bn = bi == 2 ? 0 : bi + 1;
          cmp(i, cur, cur + SBUF);
          if (i + 1 < n) stage_write(lds + LK + bn * 2 * SBUF, sA, tid);
          if (i + 3 < n) { src(i + 3, kg, vg); stage_load(sA, kg, vg); }
          __syncthreads(); ++i; bi = bn; if (i >= n) break; }
        { LAS unsigned char* cur = lds + LK + bi * 2 * SBUF; const int bn = bi == 2 ? 0 : bi + 1;
          cmp(i, cur, cur + SBUF);
          if (i + 1 < n) stage_write(lds + LK + bn * 2 * SBUF, sB, tid);
          if (i + 3 < n) { src(i + 3, kg, vg); stage_load(sB, kg, vg); }
          __syncthreads(); ++i; bi = bn; if (i >= n) break; }
    }
}
__device__ __forceinline__ void sw_block(const AttnBufs& T, const float* sink, LAS unsigned char* lds, int b, int kvh, int qblk, int tid, int wave, int fr, int fq) {
    const int q0 = 128 * qblk, wq0 = q0 + 16 * wave, tq0 = b * SEQ + wq0, khoff = kvh * 64, h0 = 3 * kvh;
    AQ<3> A; aq_init<3>(A);
#pragma unroll
    for (int q = 0; q < 3; ++q) { const bf16* qp = T.QB + (size_t)(tq0 + fr) * 384 + (h0 + q) * 64 + 8 * fq; A.qf[q][0] = *(const bf16x8*)qp; A.qf[q][1] = *(const bf16x8*)(qp + 32); }
    const int c_lo = q0 < 128 ? 2 : 0, c_hi = q0 + 256 > SEQ ? 4 : 6, nl = c_hi - c_lo;
    const int srow = tid >> 3, sseg = (tid & 7) * 8;
    chunk_pipeline(lds, nl + 4, tid,
        [&](int i, const bf16*& kg, const bf16*& vg) AINL {
            const int t0 = i < nl ? b * SEQ + q0 - 128 + 64 * (c_lo + i) : MLAT + b * CTXL + 64 * (i - nl);
            kg = T.KB + (size_t)(t0 + srow) * 128 + khoff + sseg; vg = T.VT + (size_t)(384 + khoff + srow) * MALL + t0 + sseg; },
        [&](int i, const LAS unsigned char* kb, const LAS unsigned char* vb) AINL {
            const bool loc = i < nl; const int t0 = q0 - 128 + 64 * (c_lo + i);
#pragma unroll
            for (int p = 0; p < 2; ++p) {
                const int ps = t0 + 32 * p;
                if (loc && !((ps + 31 >= wq0 - 128) && (ps <= wq0 + 15 + 128))) continue;
                const bool need = loc && !((ps >= wq0 + 15 - 128) && (ps + 31 <= wq0 + 128));
                KF kf; VF vf; lds_kf(kf, kb, 32 * p, fr, fq); lds_vf(vf, vb, 32 * p, fr, fq);
#pragma unroll
                for (int q = 0; q < 3; ++q) set_step<3>(A, q, kf, vf, [&](f32x4& sa, f32x4& sb) AINL {
                    if (need) {
#pragma unroll
                        for (int e = 0; e < 4; ++e) { const int da = (wq0 + fr) - (ps + 4 * fq + e), db = da - 16; sa[e] = (da <= 128 && da >= -128) ? sa[e] : NEGB; sb[e] = (db <= 128 && db >= -128) ? sb[e] : NEGB; }
                    } });
            } });
    sink_fold<3>(A, sink, h0, fq);
#pragma unroll
    for (int q = 0; q < 3; ++q) attn_store1(A.o[q], A.l[q], T.YB + (size_t)(tq0 + fr) * 384 + (h0 + q) * 64 + 4 * fq);
}
__device__ __forceinline__ void na_block(const AttnBufs& T, const LAS float* btab, LAS unsigned char* lds, int b, int h, int g, int tid, int wave, int fr, int fq) {
    const int hoff = h * 64, r = 4 * g + (wave >> 1), jb = 2 * (wave & 1), tq0 = b * SEQ + r * 64 + 16 * jb;
    AQ<2> A; aq_init<2>(A);
    unsigned dxp[2][2];
    int c0s[2];
#pragma unroll
    for (int jj = 0; jj < 2; ++jj) {
        const int j = jb + jj;
        const bf16* qp = T.QA + (size_t)(tq0 + 16 * jj + fr) * 384 + hoff + 8 * fq; A.qf[jj][0] = *(const bf16x8*)qp; A.qf[jj][1] = *(const bf16x8*)(qp + 32);
        const int c = 16 * j + fr, w0 = min(max(c - 8, 0), 48), c0 = min(max(16 * j - 8, 0), 32);
        c0s[jj] = c0;
#pragma unroll
        for (int x = 0; x < 2; ++x) { unsigned w = 0;
#pragma unroll
            for (int e = 0; e < 4; ++e) { const int kc = c0 + 16 * x + 4 * fq + e; const bool in = (kc >= w0) && (kc < w0 + 16); const int dx = in ? min(max(kc - c + 15, 0), 30) : 31; w |= (unsigned)(4 * dx) << (8 * e); }
            dxp[jj][x] = w; }
    }
    const int kr0 = min(max(r - 4, 0), 56), ku0 = min(max(4 * g - 4, 0), 56), nl = min(max(4 * g - 1, 0), 56) + 8 - ku0;
    const int srow = tid >> 3, sseg = (tid & 7) * 8;
    const LAS unsigned char* bh = (const LAS unsigned char*)(btab + h * (15 * 32));
    chunk_pipeline(lds, nl + 4, tid,
        [&](int i, const bf16*& kg, const bf16*& vg) AINL {
            const int t0 = i < nl ? b * SEQ + (ku0 + i) * 64 : MLAT + b * CTXL + 64 * (i - nl);
            kg = T.KA + (size_t)(t0 + srow) * 384 + hoff + sseg; vg = T.VT + (size_t)(hoff + srow) * MALL + t0 + sseg; },
        [&](int i, const LAS unsigned char* kb, const LAS unsigned char* vb) AINL {
            if (i < nl) {
                const int ky = ku0 + i;
                if ((ky >= kr0) && (ky < kr0 + 8)) {
                    const LAS unsigned char* rp_ = bh + (ky - r + 7) * 128;
#pragma unroll
                    for (int jj = 0; jj < 2; ++jj) {
                        KF kf; VF vf; lds_kf(kf, kb, c0s[jj], fr, fq); lds_vf(vf, vb, c0s[jj], fr, fq);
                        set_step<2>(A, jj, kf, vf, [&](f32x4& sa, f32x4& sb) AINL {
#pragma unroll
                            for (int e = 0; e < 4; ++e) { sa[e] += *(const LAS float*)(rp_ + ((dxp[jj][0] >> (8 * e)) & 0xffu)); sb[e] += *(const LAS float*)(rp_ + ((dxp[jj][1] >> (8 * e)) & 0xffu)); } });
                    }
                }
            } else {
#pragma unroll
                for (int p = 0; p < 2; ++p) { KF kf; VF vf; lds_kf(kf, kb, 32 * p, fr, fq); lds_vf(vf, vb, 32 * p, fr, fq);
#pragma unroll
                    for (int jj = 0; jj < 2; ++jj) set_step<2>(A, jj, kf, vf, [](f32x4&, f32x4&) AINL {}); }
            } });
#pragma unroll
    for (int jj = 0; jj < 2; ++jj) attn_store1(A.o[jj], A.l[jj], T.YA + (size_t)(tq0 + 16 * jj + fr) * 384 + hoff + 4 * fq);
}

__device__ __forceinline__ void conv_unit(const bf16* HG, bf16* YC, const LAS float* wl, const float* dwb, const float* lng, const float* lnb, int tok0, int lo, int hi, int lane) {
    const f32x4 bias = *((const f32x4*)dwb + lane);
    f32x4 acc[16];
#pragma unroll
    for (int t = 0; t < 16; ++t) acc[t] = bias;
#pragma unroll 1
    for (int ig = 0; ig < 6; ++ig) {
        u32x2 hv[8];
#pragma unroll
        for (int k = 0; k < 8; ++k) { const int r = tok0 - 15 + 8 * ig + k; hv[k] = (u32x2){0u, 0u}; if (r >= lo && r < hi) hv[k] = *(const u32x2*)(HG + (size_t)r * 256 + 4 * lane); }
#pragma unroll
        for (int k = 0; k < 8; ++k) {
            const f32x4 h = pg8::bflo(hv[k].x, hv[k].y);
            const LAS float* wp = wl + (8 * ig + k + 15) * 256 + 4 * lane;
#pragma unroll
            for (int t = 0; t < 16; ++t) acc[t] = acc[t] + h * *(const LAS f32x4*)(wp - t * 256);
        }
    }
    const f32x4 g = *((const f32x4*)lng + lane), be = *((const f32x4*)lnb + lane);
#pragma unroll
    for (int t = 0; t < 16; ++t) {
        const f32x4 v = acc[t];
        const float mu = wave_sum((v[0] + v[1]) + (v[2] + v[3])) * (1.f / 256.f);
        const f32x4 d = v - mu;
        const float var = wave_sum((d[0] * d[0] + d[1] * d[1]) + (d[2] * d[2] + d[3] * d[3])) * (1.f / 256.f);
        const float rstd = 1.f / sqrtf(var + RMS_EPS);
        const f32x4 y = d * rstd * g + be;
        u32x2 o; o.x = pk2(silu_f(y[0]), silu_f(y[1])); o.y = pk2(silu_f(y[2]), silu_f(y[3]));
        *(u32x2*)(YC + (size_t)(tok0 + t) * 256 + 4 * lane) = o;
    }
}

template <int rep> __device__ __forceinline__ void mixer_phase(KArgs pa, LAS unsigned char* lds, int l, int tid, int lane, int wave) {
    unsigned char* R = pa->ws + WS_R;
    AttnBufs T; T.QA = (const bf16*)(R + R_QA); T.KA = (const bf16*)(R + R_KA); T.QB = (const bf16*)(R + R_QB); T.KB = (const bf16*)(R + R_KB); T.VT = (const bf16*)(R + R_VT);
    T.YA = (bf16*)(R + R_YA); T.YB = (bf16*)(R + R_YB);
    const bf16* HG = (const bf16*)(R + R_HG); bf16* YC = (bf16*)(R + R_YC);
    LAS float* wl = (LAS float*)lds;
    for (int i = tid; i < 63 * 256; i += NTHR) { const int w = (i >> 8) - 15; wl[i] = (w >= 0 && w < 31) ? pa->in[15][l * 31 * 256 + w * 256 + (i & 255)] : 0.f; }
    LAS float* btab = (LAS float*)(lds + LBT);
    for (int i = tid; i < 6 * 15 * 32; i += NTHR) { const int dx = i & 31, hd = i >> 5; btab[i] = dx < 31 ? pa->in[13][l * (6 * 15 * 31) + hd * 31 + dx] * LOG2E : NEGB; }
    __syncthreads();
    const float* sink = pa->in[14] + l * 6;
    const float* dwb = pa->in[16] + l * 256; const float* lng = pa->in[17] + l * 256; const float* lnb = pa->in[18] + l * 256;
    {
        volatile LAS int* bu = (volatile LAS int*)(lds + LBU);
        constexpr int BB_SW = 2 * 32, BB_NA = 6 * 16;
        const int xb0 = (int)((unsigned)__builtin_amdgcn_s_getreg((3 << 11) | 20) & 7u);
        for (int xi = 0; xi < 8; ++xi) {
            const int b = (xb0 + xi) & 7;
            unsigned* ctrb = (unsigned*)(pa->ws + WS_CTR) + 64 * (16 + 8 * l + b);
            for (;;) {
                if (tid == 0) *bu = (int)__hip_atomic_fetch_add(ctrb, 1u, __ATOMIC_RELAXED, __HIP_MEMORY_SCOPE_AGENT);
                __syncthreads();
                const int u = __builtin_amdgcn_readfirstlane(*bu);
                __syncthreads();
                if (u >= BB_SW + BB_NA) break;
                int fr = lane & 15, fq = lane >> 4; asm volatile("" : "+v"(fr), "+v"(fq));
                if (u < BB_SW) { sw_block(T, sink, lds, b, u >> 5, u & 31, tid, wave, fr, fq); }
                else { const int v = u - BB_SW; na_block(T, btab, lds, b, v >> 4, v & 15, tid, wave, fr, fq); }
            }
        }
    }
    constexpr int B_CVL = SEQ / 16, B_CXA = 6 * 16, B_CXB = 2 * 16, B_CVC = CTXL / 16;
    const int total = B_CVL + (l == 0 ? B_CXA + B_CXB + B_CVC : 0);
    unsigned* ctr0 = (unsigned*)(pa->ws + WS_CTR) + 64 * 8 * (2 * rep + l);
    const int x0 = (int)((unsigned)__builtin_amdgcn_s_getreg((3 << 11) | 20) & 7u);
    for (int xi = 0; xi < 8; ++xi) {
        const int b = (x0 + xi) & 7;
        unsigned* ctr = ctr0 + 64 * b;
        for (;;) {
            int u = 0; if (lane == 0) u = (int)__hip_atomic_fetch_add(ctr, 1u, __ATOMIC_RELAXED, __HIP_MEMORY_SCOPE_AGENT);
            u = __builtin_amdgcn_readfirstlane(u);
            if (u >= total) break;
            int r = u;
            int fr = lane & 15, fq = lane >> 4; asm volatile("" : "+v"(fr), "+v"(fq));
            if (r < B_CVL) { const int tok0 = b * SEQ + 16 * r; conv_unit(HG, YC, wl, dwb, lng, lnb, tok0, b * SEQ, b * SEQ + SEQ, lane); continue; }
            r -= B_CVL;
            if (r < B_CXA) { const int qb = r & 15, h = r >> 4; ctxa_unit(T, b, h, qb, fr, fq); continue; }
            r -= B_CXA;
            if (r < B_CXB) { const int qb = r & 15, kvh = r >> 4; ctxb_unit(T, sink, b, kvh, qb, fr, fq); continue; }
            r -= B_CXB;
            { const int lo = MLAT + b * CTXL; conv_unit(HG, YC, wl, dwb, lng, lnb, lo + 16 * r, lo, lo + CTXL, lane); }
        }
    }
    __syncthreads();
}

#define RLX_AGENT __ATOMIC_RELAXED, __HIP_MEMORY_SCOPE_AGENT
#define XB_TMO      128
#define XB_XCNT(j)  (256  + 64 * (j))
#define XB_XSUB(j)  (1280 + 64 * (j))
#define XB_XGEN(j)  (2304 + 64 * (j))
#define XB_TOP      3328
#define XB_TOPGEN   3392
#define XCD_BAR_WORDS 3456
#define XB_SPIN_CAP (1u << 18)

__device__ __forceinline__ unsigned xb_ld(unsigned* p)              { return __hip_atomic_load(p, __ATOMIC_RELAXED, __HIP_MEMORY_SCOPE_AGENT); }
__device__ __forceinline__ unsigned xb_add(unsigned* p, unsigned v) { return __hip_atomic_fetch_add(p, v, __ATOMIC_RELAXED, __HIP_MEMORY_SCOPE_AGENT); }
__device__ __forceinline__ unsigned xb_xcc_id() { return (unsigned)__builtin_amdgcn_s_getreg((3 << 11) | 20) & 0xFu; }
#define XB_SPIN(cond, bar) do { unsigned _sp = 0; while (cond) { __builtin_amdgcn_s_sleep(1); \
    if ((++_sp & 255u) == 0u) { if (xb_ld(&(bar)[XB_TMO])) break; if (_sp > XB_SPIN_CAP) { atomicAdd(&(bar)[XB_TMO], 1u); break; } } } } while (0)

struct XcdBarrier {
    unsigned* bar; unsigned x;
    volatile LAS unsigned* st;
};

__device__ __forceinline__ XcdBarrier xcd_barrier_post(unsigned* bar, volatile LAS unsigned* st) {
    XcdBarrier b; b.bar = bar; b.x = xb_xcc_id(); b.st = st;
    if (threadIdx.x == 0) (void)xb_add(&bar[XB_XCNT(b.x)], 1u);
    return b;
}
__device__ __forceinline__ void xcd_barrier_complete(unsigned* bar, unsigned x, unsigned& nloc, unsigned& nx) {
    const unsigned G = gridDim.x * gridDim.y * gridDim.z;
    unsigned sum, cnt, mine, sp = 0u;
    for (;;) {
        sum = 0u; cnt = 0u; mine = 0u;
#pragma unroll
        for (unsigned j = 0; j < 16; ++j) { const unsigned c = xb_ld(&bar[XB_XCNT(j)]); sum += c; cnt += (c > 0u) ? 1u : 0u; mine = (j == x) ? c : mine; }
        if (sum == G) break;
        __builtin_amdgcn_s_sleep(1);
        if ((++sp & 255u) == 0u) { if (xb_ld(&bar[XB_TMO])) break; if (sp > XB_SPIN_CAP) { atomicAdd(&bar[XB_TMO], 1u); break; } }
    }
    nloc = mine > 0u ? mine : 1u; nx = cnt > 0u ? cnt : 1u;
}

__device__ __forceinline__ void xcd_barrier(const XcdBarrier& b) {
    asm volatile("s_waitcnt vmcnt(0)" ::: "memory");
    __syncthreads();
    if (threadIdx.x == 0) {
        unsigned* bar = b.bar;
        __builtin_amdgcn_s_waitcnt(0);
        unsigned nloc = b.st[0], nx = b.st[1];
        if (nloc == 0u) { xcd_barrier_complete(bar, b.x, nloc, nx); b.st[0] = nloc; b.st[1] = nx; }
        const unsigned old = xb_add(&bar[XB_XSUB(b.x)], 1u);
        const unsigned gen = old / nloc;
        if (old + 1u == (gen + 1u) * nloc) {
            __builtin_amdgcn_fence(__ATOMIC_RELEASE, "agent");
            asm volatile("s_waitcnt vmcnt(0)" ::: "memory");
            const unsigned og = xb_add(&bar[XB_TOP], 1u);
            const unsigned tg = og / nx;
            if (og + 1u == (tg + 1u) * nx) xb_add(&bar[XB_TOPGEN], 1u);
            else XB_SPIN(xb_ld(&bar[XB_TOPGEN]) == tg, bar);
            __builtin_amdgcn_fence(__ATOMIC_ACQUIRE, "agent");
            xb_add(&bar[XB_XGEN(b.x)], 1u);
            asm volatile("s_waitcnt vmcnt(0)" ::: "memory");
        } else {
            XB_SPIN(xb_ld(&bar[XB_XGEN(b.x)]) == gen, bar);
            __builtin_amdgcn_fence(__ATOMIC_ACQUIRE, "agent");
            asm volatile("s_waitcnt vmcnt(0)" ::: "memory");
        }
    }
    __syncthreads();
}

#ifdef NO_GEMM
#define GEMM_PHASE(EPI, g, S, E) do { (void)g; (void)S; (void)E; } while (0)
#else
#define GEMM_PHASE(EPI, g, S, E) pg8::gemm_phase<EPI, pg8::StaticOrder, true, true>(ldsp, g, S, E)
#endif
#define CTX_SPLITK(WDN) do { _Pragma("unroll 1") for (int sl = 0; sl < 4; ++sl) { const int kt0 = sl == 0 ? 0 : (sl == 1 ? 12 : (sl == 2 ? 24 : 34)), ntk = sl < 2 ? 12 : 10; \
        pg8::Gemm g2{(const bf16*)R + (size_t)MLAT * DFF + kt0 * 64, (WDN) + kt0 * 64, MCTX, DM, DFF, ntk * 64}; \
        pg8::StaticOrder S2; S2.init(MCTX, DM, G, (bx >= 32 * sl && bx < 32 * sl + 32) ? bx - 32 * sl : (1 << 28)); \
        pg8::EpiF32 E2{(float*)(ws + WS_P) + (size_t)sl * MCTX * DM, DM}; GEMM_PHASE(pg8::EpiF32, g2, S2, E2); } } while (0)

__global__ void __launch_bounds__(NTHR, 2) mk_fwd(Args a_unused) {
    extern __shared__ __attribute__((aligned(16))) unsigned char lds_raw[];
    LAS unsigned char* ldsp = (LAS unsigned char*)lds_raw;
    cg::grid_group grid = cg::this_grid();
#define IN(k) (pa->ph_lo <= (k) && (k) < pa->ph_hi)
#define SEAM(k) do { KArgs pa = kargs(); if (IN(k) && IN((k) + 1)) { XcdBarrier b_; b_.bar = (unsigned*)(pa->ws + WS_BAR); b_.x = xb_xcc_id(); b_.st = (volatile LAS unsigned*)(ldsp + LDS_ST); xcd_barrier(b_); } } while (0)
#define PH_BEGIN(k) { KArgs pa = kargs(); if (IN(k)) { unsigned char* ws = pa->ws; const int G = gridDim.x, bx = blockIdx.x; \
        int tid_l = threadIdx.x; asm volatile("" : "+v"(tid_l)); const int tid = tid_l, lane = tid & 63, wave = __builtin_amdgcn_readfirstlane(tid >> 6); (void)lane; (void)wave; \
        const bf16* W = (const bf16*)(ws + WS_W) + (size_t)l * WL_ELEMS; const float* modl = (const float*)(ws + WS_MOD) + (size_t)l * 9 * NMODC; \
        bf16* X = (bf16*)(ws + WS_XB); bf16* XC = (bf16*)(ws + WS_XC); bf16* H = (bf16*)(ws + WS_H); unsigned char* R = ws + WS_R; bf16* P = (bf16*)(ws + WS_P); \
        const int MP = (l == 1) ? MLAT : MALL; (void)G; (void)bx; (void)W; (void)modl; (void)X; (void)XC; (void)H; (void)R; (void)P; (void)MP;
#define PH_END(k) } } SEAM(k);
#ifndef REPMASK
#define REPMASK 0
#endif
#define REPK(kind) for (int rep_ = 0; rep_ < 1 + ((REPMASK >> (kind)) & 1); ++rep_)

        if (threadIdx.x < 2) ((volatile LAS unsigned*)(ldsp + LDS_ST))[threadIdx.x] = 0u;
    __syncthreads();
    { const int l = 0; PH_BEGIN(0) REPK(0) { prologue(pa, ldsp, tid, lane, wave); __syncthreads(); } } }
      grid.sync();
      { KArgs pa = kargs(); (void)xcd_barrier_post((unsigned*)(pa->ws + WS_BAR), (volatile LAS unsigned*)(ldsp + LDS_ST)); } }
#pragma unroll 1
    for (int l = 0; l < 2; ++l) {
        const int pb = 1 + 11 * l;
        PH_BEGIN(pb + 0) norm_phase(l == 0 ? (const void*)pa->in[0] : (const void*)X, l == 0 ? (const void*)pa->in[2] : (const void*)XC, l == 0, l == 0, pa->in[6] + l * 3 * DM, modl, 0, 1, H, MALL,
                l == 1 ? (const float*)(ws + WS_P) : (const float*)nullptr, (const float*)(ws + WS_MOD) + 8 * NMODC + 8 * DM, 0.5f, XC, lane, wave); PH_END(pb + 0)
        PH_BEGIN(pb + 1) pg8::Gemm g{H, W + WO_GU1, MALL, 2 * DFF, DM}; pg8::StaticOrder S; S.init(MALL, 2 * DFF, G, bx); pg8::EpiSwiGLU E{(bf16*)R, DFF}; REPK(1) GEMM_PHASE(pg8::EpiSwiGLU, g, S, E); PH_END(pb + 1)
        PH_BEGIN(pb + 2) { pg8::Gemm g{(const bf16*)R, W + WO_DN1, MLAT, DM, DFF}; pg8::StaticOrder S; S.init(MLAT, DM, G, bx);
            pg8::EpiResid E{l == 0 ? (const void*)pa->in[0] : (const void*)X, l == 0 ? (const void*)pa->in[2] : (const void*)XC, l == 0 ? 1 : 0, X, XC, modl + 2 * DM, 0.5f}; GEMM_PHASE(pg8::EpiResid, g, S, E); }
            CTX_SPLITK(W + WO_DN1);
        PH_END(pb + 2)
        PH_BEGIN(pb + 3) REPK(3) norm_phase(X, l == 0 ? (const void*)pa->in[2] : (const void*)XC, false, l == 0, pa->in[6] + l * 3 * DM + DM, modl, 3, 4, H, MALL,
                (const float*)(ws + WS_P), modl + 8 * NMODC + 2 * DM, 0.5f, XC, lane, wave); PH_END(pb + 3)
        PH_BEGIN(pb + 4)
            { pg8::Gemm g{H, W + WO_IN, MALL, 1792, DM}; pg8::StaticOrder S; S.init(MALL, 1792, G, bx);
              pg8::EpiIn1 E{(bf16*)(R + R_QB), (bf16*)(R + R_KB), (bf16*)(R + R_QA), (bf16*)(R + R_KA), (bf16*)(R + R_HG), (const float*)(ws + WS_ROPE), SCL2}; GEMM_PHASE(pg8::EpiIn1, g, S, E); }
            { pg8::Gemm g{W + WO_IN + (size_t)1792 * DM, H, 512, MALL, DM}; pg8::StaticOrder S; S.init(512, MALL, G, G - 1 - bx); pg8::EpiBf16 E{(bf16*)(R + R_VT), MALL};   GEMM_PHASE(pg8::EpiBf16, g, S, E); }
        PH_END(pb + 4)
        #ifndef NO_MIX
        PH_BEGIN(pb + 5) mixer_phase<0>(pa, ldsp, l, tid, lane, wave);
        PH_END(pb + 5)
#endif
        PH_BEGIN(pb + 6)
            REPK(6)
#pragma unroll 1
            for (int br = 0; br < 3; ++br) {
                const bf16* Y = (const bf16*)(R + (br == 0 ? R_YA : (br == 1 ? R_YB : R_YC))); const int Kb = br == 2 ? 256 : 384;
                const bf16* Wb = W + (br == 0 ? WO_OA : (br == 1 ? WO_OB : WO_OC));
                { pg8::Gemm g{Y, Wb, MP, DM, Kb}; pg8::StaticOrder S; S.init(MP, DM, G, bx); pg8::EpiBf16 E{P, DM}; GEMM_PHASE(pg8::EpiBf16, g, S, E); }
                { pg8::Gemm g{H, W + WO_IN + (size_t)(2304 + 1024 * br) * DM, MP, DM, DM}; pg8::StaticOrder S; S.init(MP, DM, G, bx);
                  pg8::EpiGate E{P, (bf16*)R, pa->in[12] + l * 3072 + br * 1024, br}; GEMM_PHASE(pg8::EpiGate, g, S, E); }
            }
        PH_END(pb + 6)
        PH_BEGIN(pb + 7) pg8::Gemm g{P, W + WO_WO, MP, DM, DM}; pg8::StaticOrder S; S.init(MP, DM, G, bx); pg8::EpiResid E{X, XC, 0, X, XC, modl + 5 * DM, 1.0f}; GEMM_PHASE(pg8::EpiResid, g, S, E); PH_END(pb + 7)
        PH_BEGIN(pb + 8) norm_phase(X, XC, false, false, pa->in[6] + l * 3 * DM + 2 * DM, modl, 6, 7, H, MP, (const float*)nullptr, (const float*)nullptr, 0.f, XC, lane, wave); PH_END(pb + 8)
        PH_BEGIN(pb + 9) pg8::Gemm g{H, W + WO_GU2, MP, 2 * DFF, DM}; pg8::StaticOrder S; S.init(MP, 2 * DFF, G, bx); pg8::EpiSwiGLU E{(bf16*)R, DFF}; GEMM_PHASE(pg8::EpiSwiGLU, g, S, E); PH_END(pb + 9)
        PH_BEGIN(pb + 10) { pg8::Gemm g{(const bf16*)R, W + WO_DN2, MLAT, DM, DFF}; pg8::StaticOrder S; S.init(MLAT, DM, G, bx); pg8::EpiResid E{X, XC, 0, X, XC, modl + 8 * DM, 0.5f}; GEMM_PHASE(pg8::EpiResid, g, S, E); }
            if (l == 0) CTX_SPLITK(W + WO_DN2);
        PH_END(pb + 10)
    }
#ifdef PROBE_SYNCS
    for (int i_ = 0; i_ < 24; ++i_) grid.sync();
#endif
    { const int l = 0; PH_BEGIN(23) final_norm(X, pa->out, pa->in[23], lane, wave); } } }
#undef IN
#undef SEAM
}

#ifndef MK_MULTI
#define MK_MULTI 0
#endif
extern "C" void kernel_launch(void* const* d_in, const int* in_sizes, int n_in, void* d_out, int out_size, void* d_ws, size_t ws_size, hipStream_t stream) {
    static int grid = 0;
    if (grid == 0) {
        if (n_in != 24 || out_size != MLAT * DM || ws_size < WS_END) { fprintf(stderr, "kernel_launch: unexpected shapes (n_in %d out %d ws %zu)\n", n_in, out_size, ws_size); grid = -1; return; }
        int dev = 0, cus = 0, per_cu = 0;
        if (hipGetDevice(&dev) != hipSuccess || hipDeviceGetAttribute(&cus, hipDeviceAttributeMultiprocessorCount, dev) != hipSuccess) { grid = -1; return; }
        if (hipFuncSetAttribute((const void*)mk_fwd, hipFuncAttributeMaxDynamicSharedMemorySize, LDS_BYTES) != hipSuccess) { fprintf(stderr, "kernel_launch: hipFuncSetAttribute failed\n"); grid = -1; return; }
        if (hipOccupancyMaxActiveBlocksPerMultiprocessor(&per_cu, (const void*)mk_fwd, NTHR, LDS_BYTES) != hipSuccess || per_cu < 1) { fprintf(stderr, "kernel_launch: occupancy query says %d\n", per_cu); per_cu = 1; }
        (void)hipGetLastError();
        grid = cus * per_cu;
    }
    if (grid < 0) return;
    Args a{};
    for (int i = 0; i < 24; ++i) a.in[i] = (const float*)d_in[i];
    a.out = (float*)d_out; a.ws = (unsigned char*)d_ws;
#if MK_MULTI
    for (int p = 0; p < 24; ++p) { a.ph_lo = p; a.ph_hi = p + 1; hipLaunchKernelGGL(mk_fwd, dim3(grid), dim3(NTHR), LDS_BYTES, stream, a); }
#else
    a.ph_lo = 0; a.ph_hi = 24;
    void* args[] = {&a};
    hipError_t e = hipLaunchCooperativeKernel((const void*)mk_fwd, dim3(grid), dim3(NTHR), args, LDS_BYTES, stream);
    if (e != hipSuccess) fprintf(stderr, "cooperative launch failed: %s (grid %d)\n", hipGetErrorString(e), grid);
#endif
}
```

```cpp
#include <hip/hip_runtime.h>
#include <hip/hip_cooperative_groups.h>
#include <cstdio>
#include <cstdint>
namespace cg = cooperative_groups;
namespace pg8 {
#define PG8_LAS __attribute__((address_space(3)))
typedef unsigned short bf16_t;
typedef short bf16x8 __attribute__((ext_vector_type(8)));
typedef float f32x4 __attribute__((ext_vector_type(4)));
typedef unsigned u32x4 __attribute__((ext_vector_type(4)));
constexpr int BM = 256, BK = 64, HALF = 128, HTB = HALF * BK * 2  , STAGE_BYTES = 8 * HTB, NXCD = 8, WGM = 8;

__host__ __device__ __forceinline__ int lds_byte(int r, int c) { const int st = (r >> 4) * 2 + (c >> 5), rr = r & 15, cc = c & 31, ob = rr * 64 + cc * 2; return st * 1024 + (ob ^ (((ob >> 9) & 1) << 5)); }
__host__ __device__ __forceinline__ void stage_rc(int b, int& R, int& C) { const int st = b / 1024, sb = b % 1024, swz = sb ^ (((sb >> 9) & 1) << 5); R = (st >> 1) * 16 + swz / 64; C = (st & 1) * 32 + (swz % 64) / 2; }
__host__ __device__ __forceinline__ int perm32(int rho) { const int n = rho >> 4, i = rho & 15; return 8 * (i >> 2) + 4 * n + (i & 3); }

struct Unit { int pm, pn; };
struct Gemm { const bf16_t* A; const bf16_t* Bt; int M, N, K; int Kx; };

struct StaticOrder {
    int nM, nN, nwg, G, c;
    __host__ __device__ void init(int M, int N, int G_, int c_) { nM = M / BM; nN = N / BM; nwg = nM * nN; G = G_; c = c_; }
    __host__ __device__ bool next(int i, Unit& u) const {
        const long L = (long)i * G + c; if (L >= nwg) return false;
        int wgid = (int)L; { const int q = nwg / NXCD, r = nwg % NXCD, xcd = wgid % NXCD, off = wgid / NXCD; wgid = (xcd < r ? xcd * (q + 1) : r * (q + 1) + (xcd - r) * q) + off; }
        const int nig = WGM * nN, gid = wgid / nig, fm = gid * WGM, gsz = (nM - fm) < WGM ? (nM - fm) : WGM;
        u.pm = fm + ((wgid % nig) % gsz); u.pn = (wgid % nig) / gsz; return true;
    }
    __device__ __forceinline__ void a_ready(const Unit&) const {}
    __device__ __forceinline__ void done(const Unit&) const {}
};

__device__ __forceinline__ unsigned cvt_pk_bf16(float lo, float hi) { unsigned r; asm volatile("v_cvt_pk_bf16_f32 %0, %1, %2" : "=v"(r) : "v"(lo), "v"(hi)); return r; }
__device__ __forceinline__ float sigm(float x) { return __builtin_amdgcn_rcpf(1.f + __expf(-x)); }
__device__ __forceinline__ u32x4 pack8(const f32x4& v0, const f32x4& v1) { u32x4 w; w.x = cvt_pk_bf16(v0[0], v0[1]); w.y = cvt_pk_bf16(v0[2], v0[3]); w.z = cvt_pk_bf16(v1[0], v1[1]); w.w = cvt_pk_bf16(v1[2], v1[3]); return w; }
__device__ __forceinline__ f32x4 bflo(unsigned a, unsigned b) { f32x4 r; r[0] = __builtin_bit_cast(float, a << 16); r[1] = __builtin_bit_cast(float, a & 0xffff0000u); r[2] = __builtin_bit_cast(float, b << 16); r[3] = __builtin_bit_cast(float, b & 0xffff0000u); return r; }

struct EpiSwiGLU {
    static constexpr bool PERM = true, AFTER_DRAIN = false;
    bf16_t* O; int ldc;
    __device__ __forceinline__ void operator()(const f32x4 (&acc)[2][2][4][2], const Unit& u, int wr, int wc, int fr, int fq) const {
        const int row0 = u.pm * BM + wr * 64 + fr, col0 = u.pn * HALF + wc * 32 + 8 * fq;
#pragma unroll
        for (int ai = 0; ai < 2; ++ai)
#pragma unroll
            for (int m = 0; m < 4; ++m) {
                f32x4 v[2];
#pragma unroll
                for (int n = 0; n < 2; ++n)
#pragma unroll
                    for (int j = 0; j < 4; ++j) { const float a = acc[ai][0][m][n][j], b = acc[ai][1][m][n][j]; v[n][j] = a * sigm(a) * b; }
                *(u32x4*)(O + (size_t)(row0 + ai * HALF + m * 16) * ldc + col0) = pack8(v[0], v[1]);
            }
    }
};

struct EpiResid {
    static constexpr bool PERM = true, AFTER_DRAIN = false;
    const void* srcL; const void* srcC; int src_f32; bf16_t* dstL; bf16_t* dstC; const float* gate; float coef;
    __device__ __forceinline__ void operator()(const f32x4 (&acc)[2][2][4][2], const Unit& u, int wr, int wc, int fr, int fq) const {
        const bool lat = u.pm < 128;
        const size_t tile0 = (size_t)(lat ? u.pm : u.pm - 128) * BM * 1024;
        const void* srcv = lat ? srcL : srcC;
        bf16_t* dst = (lat ? dstL : dstC) + tile0;
        const float* g = gate + (lat ? (u.pm >> 4) : 8) * 9216;
        const int rl = wr * 64 + fr, col0 = u.pn * BM + wc * 32 + 8 * fq;
        f32x4 gv[2][2];
#pragma unroll
        for (int bj = 0; bj < 2; ++bj)
#pragma unroll
            for (int n = 0; n < 2; ++n) gv[bj][n] = *(const f32x4*)(g + col0 + bj * HALF + 4 * n) * coef;
#pragma unroll
        for (int ai = 0; ai < 2; ++ai)
#pragma unroll
            for (int m = 0; m < 4; ++m)
#pragma unroll
                for (int bj = 0; bj < 2; ++bj) {
                    const size_t off = (size_t)(rl + ai * HALF + m * 16) * 1024 + col0 + bj * HALF;
                    f32x4 x0, x1;
                    if (src_f32) { const float* sp = (const float*)srcv + tile0 + off; x0 = *(const f32x4*)sp; x1 = *(const f32x4*)(sp + 4); }
                    else { const u32x4 w = *(const u32x4*)((const bf16_t*)srcv + tile0 + off); x0 = bflo(w.x, w.y); x1 = bflo(w.z, w.w); }
                    *(u32x4*)(dst + off) = pack8(x0 + gv[bj][0] * acc[ai][bj][m][0], x1 + gv[bj][1] * acc[ai][bj][m][1]);
                }
    }
};

struct EpiIn1 {
    static constexpr bool PERM = true, AFTER_DRAIN = false;
    bf16_t *QB, *KB, *QA, *KA, *HG; const float* rope; float qs;
    __device__ __forceinline__ void operator()(const f32x4 (&acc)[2][2][4][2], const Unit& u, int wr, int wc, int fr, int fq) const {
        const int row0 = u.pm * BM + wr * 64 + fr; const bool lat = u.pm < 128; const int pn = u.pn;
        if (pn < 2) {
            const int g8 = 4 * pn + wc; bf16_t* dst = g8 < 6 ? QB + g8 * 64 : KB + (g8 - 6) * 64; const int ld = g8 < 6 ? 384 : 128; const float sc = g8 < 6 ? qs : 1.f;
#pragma unroll
            for (int ai = 0; ai < 2; ++ai)
#pragma unroll
                for (int m = 0; m < 4; ++m) {
                    const int row = row0 + ai * HALF + m * 16;
                    f32x4 y1[2], y2[2];
                    if (lat) {
                        const int t = row & 4095, pos = fq < 2 ? (t >> 6) : (t & 63); const float* rp = rope + pos * 16 + 8 * (fq & 1);
#pragma unroll
                        for (int n = 0; n < 2; ++n) { const f32x4 c = *(const f32x4*)(rp + 4 * n), s = *(const f32x4*)(rp + 1024 + 4 * n);
                            const f32x4 x1 = acc[ai][0][m][n], x2 = acc[ai][1][m][n]; y1[n] = x1 * c - x2 * s; y2[n] = x1 * s + x2 * c; }
                    } else { y1[0] = acc[ai][0][m][0]; y1[1] = acc[ai][0][m][1]; y2[0] = acc[ai][1][m][0]; y2[1] = acc[ai][1][m][1]; }
                    bf16_t* rowp = dst + (size_t)row * ld + 8 * fq;
                    *(u32x4*)(rowp) = pack8(y1[0] * sc, y1[1] * sc); *(u32x4*)(rowp + 32) = pack8(y2[0] * sc, y2[1] * sc);
                }
        } else if (pn < 5) {
#pragma unroll
            for (int bj = 0; bj < 2; ++bj) {
                const int c = (pn - 2) * BM + bj * HALF + wc * 32 + 8 * fq; bf16_t* dst = c < 384 ? QA + c : KA + (c - 384); const float sc = c < 384 ? qs : 1.f;
#pragma unroll
                for (int ai = 0; ai < 2; ++ai)
#pragma unroll
                    for (int m = 0; m < 4; ++m) *(u32x4*)(dst + (size_t)(row0 + ai * HALF + m * 16) * 384) = pack8(acc[ai][bj][m][0] * sc, acc[ai][bj][m][1] * sc);
            }
        } else {
            const int col = (pn - 5) * HALF + wc * 32 + 8 * fq;
#pragma unroll
            for (int ai = 0; ai < 2; ++ai)
#pragma unroll
                for (int m = 0; m < 4; ++m) {
                    f32x4 v[2];
#pragma unroll
                    for (int n = 0; n < 2; ++n)
#pragma unroll
                        for (int j = 0; j < 4; ++j) v[n][j] = acc[ai][0][m][n][j] * sigm(acc[ai][1][m][n][j]);
                    *(u32x4*)(HG + (size_t)(row0 + ai * HALF + m * 16) * 256 + col) = pack8(v[0], v[1]);
                }
        }
    }
};

struct EpiBf16 {
    static constexpr bool PERM = true, AFTER_DRAIN = false;
    bf16_t* O; int ldc;
    __device__ __forceinline__ void operator()(const f32x4 (&acc)[2][2][4][2], const Unit& u, int wr, int wc, int fr, int fq) const {
        const int row0 = u.pm * BM + wr * 64 + fr, col0 = u.pn * BM + wc * 32 + 8 * fq;
#pragma unroll
        for (int ai = 0; ai < 2; ++ai)
#pragma unroll
            for (int m = 0; m < 4; ++m)
#pragma unroll
                for (int bj = 0; bj < 2; ++bj) *(u32x4*)(O + (size_t)(row0 + ai * HALF + m * 16) * ldc + col0 + bj * HALF) = pack8(acc[ai][bj][m][0], acc[ai][bj][m][1]);
    }
};

struct EpiF32 {
    static constexpr bool PERM = true, AFTER_DRAIN = false;
    float* O; int ldc;
    __device__ __forceinline__ void operator()(const f32x4 (&acc)[2][2][4][2], const Unit& u, int wr, int wc, int fr, int fq) const {
        const int row0 = u.pm * BM + wr * 64 + fr, col0 = u.pn * BM + wc * 32 + 8 * fq;
#pragma unroll
        for (int ai = 0; ai < 2; ++ai)
#pragma unroll
            for (int m = 0; m < 4; ++m)
#pragma unroll
                for (int bj = 0; bj < 2; ++bj) { float* o = O + (size_t)(row0 + ai * HALF + m * 16) * ldc + col0 + bj * HALF; *(f32x4*)o = acc[ai][bj][m][0]; *(f32x4*)(o + 4) = acc[ai][bj][m][1]; }
    }
};

struct EpiGate {
    static constexpr bool PERM = true, AFTER_DRAIN = false;
    bf16_t* P; bf16_t* T; const float* bg; int br;
    __device__ __forceinline__ void operator()(const f32x4 (&acc)[2][2][4][2], const Unit& u, int wr, int wc, int fr, int fq) const {
        const int row0 = u.pm * BM + wr * 64 + fr, col0 = u.pn * BM + wc * 32 + 8 * fq;
        f32x4 bv[2][2];
#pragma unroll
        for (int bj = 0; bj < 2; ++bj)
#pragma unroll
            for (int n = 0; n < 2; ++n) bv[bj][n] = *(const f32x4*)(bg + col0 + bj * HALF + 4 * n);
#pragma unroll
        for (int ai = 0; ai < 2; ++ai)
#pragma unroll
            for (int m = 0; m < 4; ++m)
#pragma unroll
                for (int bj = 0; bj < 2; ++bj) {
                    const size_t off = (size_t)(row0 + ai * HALF + m * 16) * 1024 + col0 + bj * HALF;
                    const u32x4 pw = *(const u32x4*)(P + off);
                    const f32x4 p0 = bflo(pw.x, pw.y), p1 = bflo(pw.z, pw.w);
                    f32x4 t0, t1;
#pragma unroll
                    for (int j = 0; j < 4; ++j) { t0[j] = sigm(acc[ai][bj][m][0][j] + bv[bj][0][j]) * p0[j]; t1[j] = sigm(acc[ai][bj][m][1][j] + bv[bj][1][j]) * p1[j]; }
                    if (br != 0) { const u32x4 tw = *(const u32x4*)(T + off); t0 = t0 + bflo(tw.x, tw.y); t1 = t1 + bflo(tw.z, tw.w); }
                    *(u32x4*)((br == 2 ? P : T) + off) = pack8(t0, t1);
                }
    }
};

template <class Epi, class Sched, bool ALIGN_EPI = false, bool SP2 = false>
__device__ __forceinline__ void gemm_phase(PG8_LAS unsigned char* lds, const Gemm g, const Sched& S, const Epi& E) {
    int tid_l = threadIdx.x; asm volatile("" : "+v"(tid_l));
    const int tid = tid_l, wid = __builtin_amdgcn_readfirstlane(tid >> 6), lane = tid & 63, wr = wid >> 2, wc = wid & 3, fr = lane & 15, fq = lane >> 4;
    const int K = g.K, nt = (g.Kx ? g.Kx : K) / BK;
    unsigned voffA[2], voffB[2];
#pragma unroll
    for (int i = 0; i < 2; ++i) { int R, C; stage_rc(tid * 16 + i * 8192, R, C); const int Rb = Epi::PERM ? ((R & ~31) + perm32(R & 31)) : R;
        voffA[i] = (unsigned)(R * K + C) * 2u; voffB[i] = (unsigned)(Rb * K + C) * 2u; }
    const size_t kstep = (size_t)(BK * 2);
    const size_t hstep = (size_t)HALF * K * 2;
    const size_t tstep = 2 * hstep;
    const unsigned ldsw = (unsigned)wid * 1024u;
    const int aoff = lds_byte(wr * 64 + fr, fq * 8), boff = lds_byte(wc * 32 + fr, fq * 8);
#define PG8_SA(b, h) (((b) * 2 + (h)) * HTB)
#define PG8_SB(b, h) ((4 + (b) * 2 + (h)) * HTB)
#define PG8_STAGE(bufoff, gbase, voff) do { _Pragma("unroll") for (int _i = 0; _i < 2; ++_i) \
        __builtin_amdgcn_global_load_lds((const unsigned*)((const char*)(gbase) + (voff)[_i]), (PG8_LAS unsigned*)(lds + (bufoff) + ldsw + _i * 8192), 16, 0, 0); } while (0)
#define PG8_LDA(dst, b, h) do { _Pragma("unroll") for (int m = 0; m < 4; ++m) _Pragma("unroll") for (int k = 0; k < 2; ++k) dst[m][k] = *(const PG8_LAS bf16x8*)(lds + PG8_SA(b, h) + aoff + m * 2048 + k * 1024); } while (0)
#define PG8_LDB(dst, b, h) do { _Pragma("unroll") for (int n = 0; n < 2; ++n) _Pragma("unroll") for (int k = 0; k < 2; ++k) dst[n][k] = *(const PG8_LAS bf16x8*)(lds + PG8_SB(b, h) + boff + n * 2048 + k * 1024); } while (0)
#define PG8_MMA(ai, bj, At, Bt) do { __builtin_amdgcn_s_setprio(1); _Pragma("unroll") for (int m = 0; m < 4; ++m) _Pragma("unroll") for (int n = 0; n < 2; ++n) _Pragma("unroll") for (int k = 0; k < 2; ++k) \
        acc[ai][bj][m][n] = __builtin_amdgcn_mfma_f32_16x16x32_bf16(Bt[n][k], At[m][k], acc[ai][bj][m][n], 0, 0, 0); __builtin_amdgcn_s_setprio(0); } while (0)
#define PG8_WAIT_V(n) asm volatile("s_waitcnt vmcnt(" #n ")" ::: "memory")
#define PG8_WAIT_L(n) asm volatile("s_waitcnt lgkmcnt(" #n ")" ::: "memory")
#define PG8_BAR __builtin_amdgcn_s_barrier()
#define PG8_SCHED __builtin_amdgcn_sched_barrier(0)
    Unit cur, nxt; int ui = 0;
    if (!S.next(0, cur)) return;
    f32x4 acc[2][2][4][2];
#pragma unroll
    for (int a = 0; a < 2; ++a)
#pragma unroll
        for (int b = 0; b < 2; ++b)
#pragma unroll
            for (int m = 0; m < 4; ++m)
#pragma unroll
                for (int n = 0; n < 2; ++n) acc[a][b][m][n] = (f32x4){0.f, 0.f, 0.f, 0.f};
    bf16x8 At[4][2], B0[2][2], B1[2][2];
    const char* cA = (const char*)g.A + (size_t)cur.pm * tstep; const char* cB = (const char*)g.Bt + (size_t)cur.pn * tstep;
    S.a_ready(cur);
    if constexpr (SP2) {
        PG8_STAGE(PG8_SB(0, 0), cB, voffB); PG8_STAGE(PG8_SB(0, 1), cB + hstep, voffB); PG8_STAGE(PG8_SA(0, 0), cA, voffA); PG8_STAGE(PG8_SA(0, 1), cA + hstep, voffA);
        if (wr == 1) PG8_BAR;
        PG8_WAIT_V(2); PG8_BAR;
        PG8_STAGE(PG8_SB(1, 0), cB + kstep, voffB); PG8_STAGE(PG8_SA(1, 0), cA + kstep, voffA); PG8_STAGE(PG8_SB(1, 1), cB + hstep + kstep, voffB);
        PG8_WAIT_V(6); PG8_BAR;
    } else {
        PG8_STAGE(PG8_SB(0, 0), cB, voffB); PG8_STAGE(PG8_SA(0, 0), cA, voffA); PG8_STAGE(PG8_SB(0, 1), cB + hstep, voffB); PG8_STAGE(PG8_SA(0, 1), cA + hstep, voffA);
        if (wr == 1) PG8_BAR;
        PG8_WAIT_V(4); PG8_BAR;
        PG8_STAGE(PG8_SB(1, 0), cB + kstep, voffB); PG8_STAGE(PG8_SA(1, 0), cA + kstep, voffA); PG8_STAGE(PG8_SB(1, 1), cB + hstep + kstep, voffB);
        PG8_WAIT_V(6); PG8_BAR;
    }
    for (;;) {
        const bool has_next = S.next(ui + 1, nxt);
        const char* nA = has_next ? (const char*)g.A + (size_t)nxt.pm * tstep : cA; const char* nB = has_next ? (const char*)g.Bt + (size_t)nxt.pn * tstep : cB;
        for (int t = 0; t < nt; t += 2) {
            const bool last = (t == nt - 2);
            const char* a1 = cA + (size_t)(t + 1) * kstep;
            const char* a2 = last ? nA : cA + (size_t)(t + 2) * kstep; const char* b2 = last ? nB : cB + (size_t)(t + 2) * kstep;
            const char* a3 = a2 + kstep; const char* b3 = b2 + kstep;
            if (last && has_next) S.a_ready(nxt);
            if constexpr (SP2) {
            PG8_LDB(B0, 0, 0); PG8_LDB(B1, 0, 1); PG8_SCHED; PG8_LDA(At, 0, 0); PG8_STAGE(PG8_SA(1, 1), a1 + hstep, voffA);
            PG8_WAIT_V(8); PG8_WAIT_L(0); PG8_BAR; PG8_MMA(0, 0, At, B0); PG8_MMA(0, 1, At, B1); PG8_BAR; PG8_SCHED;
            PG8_LDA(At, 0, 1); PG8_STAGE(PG8_SB(0, 0), b2, voffB); PG8_STAGE(PG8_SB(0, 1), b2 + hstep, voffB); PG8_STAGE(PG8_SA(0, 0), a2, voffA);
            PG8_WAIT_V(8); PG8_WAIT_L(0); PG8_BAR; PG8_MMA(1, 0, At, B0); PG8_MMA(1, 1, At, B1); PG8_BAR; PG8_SCHED;
            PG8_LDB(B0, 1, 0); PG8_LDB(B1, 1, 1); PG8_SCHED; PG8_LDA(At, 1, 0); PG8_STAGE(PG8_SA(0, 1), a2 + hstep, voffA);
            PG8_WAIT_V(8); PG8_WAIT_L(0); PG8_BAR; PG8_MMA(0, 0, At, B0); PG8_MMA(0, 1, At, B1); PG8_BAR; PG8_SCHED;
            PG8_LDA(At, 1, 1); PG8_STAGE(PG8_SB(1, 0), b3, voffB); PG8_STAGE(PG8_SB(1, 1), b3 + hstep, voffB); PG8_STAGE(PG8_SA(1, 0), a3, voffA);
            PG8_WAIT_V(8); PG8_WAIT_L(0); PG8_BAR; PG8_MMA(1, 0, At, B0); PG8_MMA(1, 1, At, B1); PG8_BAR; PG8_SCHED;
            } else {
            PG8_LDB(B0, 0, 0); PG8_SCHED; PG8_LDA(At, 0, 0); PG8_STAGE(PG8_SA(1, 1), a1 + hstep, voffA);
            PG8_WAIT_L(8); PG8_BAR; PG8_WAIT_L(0); PG8_MMA(0, 0, At, B0); PG8_BAR; PG8_SCHED;
            PG8_LDB(B1, 0, 1); PG8_STAGE(PG8_SB(0, 0), b2, voffB);
            PG8_BAR; PG8_WAIT_L(0); PG8_MMA(0, 1, At, B1); PG8_BAR;
            PG8_LDA(At, 0, 1); PG8_STAGE(PG8_SA(0, 0), a2, voffA);
            PG8_BAR; PG8_WAIT_L(0); PG8_MMA(1, 0, At, B0); PG8_BAR; PG8_SCHED;
            PG8_STAGE(PG8_SB(0, 1), b2 + hstep, voffB);
            PG8_WAIT_V(6); PG8_BAR; PG8_MMA(1, 1, At, B1); PG8_BAR;
            PG8_LDB(B0, 1, 0); PG8_SCHED; PG8_LDA(At, 1, 0); PG8_STAGE(PG8_SA(0, 1), a2 + hstep, voffA);
            PG8_WAIT_L(8); PG8_BAR; PG8_WAIT_L(0); PG8_MMA(0, 0, At, B0); PG8_BAR; PG8_SCHED;
            PG8_LDB(B1, 1, 1); PG8_STAGE(PG8_SB(1, 0), b3, voffB);
            PG8_BAR; PG8_WAIT_L(0); PG8_MMA(0, 1, At, B1); PG8_BAR;
            PG8_LDA(At, 1, 1); PG8_STAGE(PG8_SA(1, 0), a3, voffA);
            PG8_BAR; PG8_WAIT_L(0); PG8_MMA(1, 0, At, B0); PG8_BAR; PG8_SCHED;
            PG8_STAGE(PG8_SB(1, 1), b3 + hstep, voffB);
            PG8_WAIT_V(6); PG8_BAR; PG8_MMA(1, 1, At, B1); PG8_BAR;
            }
        }
        if constexpr (ALIGN_EPI) { if (wr == 0) PG8_BAR; }
        if constexpr (!Epi::AFTER_DRAIN) { E(acc, cur, wr, wc, fr, fq); S.done(cur); }
        if (!has_next) break;
#pragma unroll
        for (int a = 0; a < 2; ++a)
#pragma unroll
            for (int b = 0; b < 2; ++b)
#pragma unroll
                for (int m = 0; m < 4; ++m)
#pragma unroll
                    for (int n = 0; n < 2; ++n) acc[a][b][m][n] = (f32x4){0.f, 0.f, 0.f, 0.f};
        cur = nxt; cA = nA; cB = nB; ++ui;
        if constexpr (ALIGN_EPI) { if (wr == 1) PG8_BAR; }
    }
    PG8_WAIT_V(0);
    if constexpr (!ALIGN_EPI) { if (wr == 0) PG8_BAR; }
    PG8_BAR;
    if constexpr (Epi::AFTER_DRAIN) { E.fused(acc, cur, wr, wc, fr, fq, lds, wid, lane); S.done(cur); }
#undef PG8_SA
#undef PG8_SB
#undef PG8_STAGE
#undef PG8_LDA
#undef PG8_LDB
#undef PG8_MMA
#undef PG8_WAIT_V
#undef PG8_WAIT_L
#undef PG8_BAR
#undef PG8_SCHED
}
}

#define LAS __attribute__((address_space(3)))
typedef unsigned short bf16;
typedef float f32x4 __attribute__((ext_vector_type(4)));
typedef short bf16x8 __attribute__((ext_vector_type(8)));
typedef unsigned u32x4 __attribute__((ext_vector_type(4)));
typedef unsigned u32x2 __attribute__((ext_vector_type(2)));

constexpr int DM = 1024, NB = 8, SEQ = 4096, MLAT = NB * SEQ, CTXL = 256, MCTX = NB * CTXL, MALL = MLAT + MCTX, DFF = 2816;
constexpr int NMODC = 9 * DM, IN_DIM = 5376;
constexpr float LOG2E = 1.4426950408889634f, SCL2 = 0.125f * LOG2E, NEGB = -1e30f, RMS_EPS = 1e-6f;
constexpr int NWAVES = 8, NTHR = 512;
constexpr int LDS_BYTES = 147456, LDS_ST = 147456 - 64;

constexpr size_t MiB = 1u << 20;
constexpr size_t WS_MOD = 0, WS_ROPE = 1 * MiB, WS_CTR = 1 * MiB + 65536, WS_BAR = 1 * MiB + 131072, WS_XC = 2 * MiB, WS_H = 10 * MiB, WS_R = 78 * MiB, WS_P = 282 * MiB, WS_W = 350 * MiB, WS_XB = 445 * MiB, WS_END = 509 * MiB;
constexpr size_t R_QB = 0, R_KB = R_QB + (size_t)MALL * 384 * 2, R_QA = R_KB + (size_t)MALL * 128 * 2, R_KA = R_QA + (size_t)MALL * 384 * 2, R_HG = R_KA + (size_t)MALL * 384 * 2,
                 R_VT = R_HG + (size_t)MALL * 256 * 2, R_YA = R_VT + (size_t)MALL * 512 * 2, R_YB = R_YA + (size_t)MALL * 384 * 2, R_YC = R_YB + (size_t)MALL * 384 * 2, R_END = R_YC + (size_t)MALL * 256 * 2;
static_assert(R_YA == (size_t)MALL * 1024 * 4 && R_END <= 204 * MiB && (size_t)MALL * DFF * 2 <= 204 * MiB, "region map");
constexpr size_t WO_GU1 = 0, WO_DN1 = 5767168, WO_GU2 = 8650752, WO_DN2 = 14417920, WO_IN = 17301504, WO_OA = 22806528, WO_OB = 23199744, WO_OC = 23592960, WO_WO = 23855104, WL_ELEMS = 24903680;
static_assert(WS_W + 2 * WL_ELEMS * 2 <= WS_XB && WS_XB + (size_t)MLAT * DM * 2 <= WS_END, "weights / residual map");

struct Args { const float* in[24]; float* out; unsigned char* ws; int ph_lo, ph_hi; };
typedef const __attribute__((address_space(4))) Args* KArgs;
__device__ __forceinline__ KArgs kargs() { KArgs p = (KArgs)__builtin_amdgcn_kernarg_segment_ptr(); asm volatile("" : "+s"(p)); return p; }

__device__ __forceinline__ float wave_sum(float v) {
#pragma unroll
    for (int o = 1; o < 64; o <<= 1) v += __shfl_xor(v, o);
    return v;
}
__device__ __forceinline__ unsigned pk2(float lo, float hi) { return pg8::cvt_pk_bf16(lo, hi); }
__device__ __forceinline__ float silu_f(float x) { return x * __builtin_amdgcn_rcpf(1.f + __expf(-x)); }
__device__ __forceinline__ float ex2(float x) { return __builtin_amdgcn_exp2f(x); }

__device__ __forceinline__ int gu_row(int n0) { const int h = n0 >= DFF, r = n0 - h * DFF; return 256 * (r >> 7) + 128 * h + (r & 127); }
__device__ __forceinline__ int in_row(int n0) {
    if (n0 < 768) return 512 + n0;
    if (n0 < 1152) return 1792 + (n0 - 768);
    if (n0 < 1664) { const int s = n0 - 1152, g8 = s >> 6, hf = (s >> 5) & 1; return 256 * (g8 >> 2) + 128 * hf + 32 * (g8 & 3); }
    if (n0 < 1792) return 1792 + 384 + (n0 - 1664);
    if (n0 < 2304) { const int s = n0 - 1792, hf = s >> 8, r = s & 255; return 1280 + 256 * (r >> 7) + 128 * hf + (r & 127); }
    return n0;
}
__device__ __forceinline__ void transpose_item(const float* W, int K, int N, bf16* WT, int k0, int n0, int drow0, LAS float* scr, int lane) {
#pragma unroll 8
    for (int i = 0; i < 32; ++i) { const int kk = 2 * i + (lane >> 5); scr[kk * 33 + (lane & 31)] = __builtin_nontemporal_load(W + (size_t)(k0 + kk) * N + n0 + (lane & 31)); }
    asm volatile("s_waitcnt lgkmcnt(0)" ::: "memory");
    const int c = lane & 7;
#pragma unroll
    for (int j = 0; j < 4; ++j) { const int n = (lane >> 3) + 8 * j; const LAS float* s = scr + (8 * c) * 33 + n;
        u32x4 o; o.x = pk2(s[0 * 33], s[1 * 33]); o.y = pk2(s[2 * 33], s[3 * 33]); o.z = pk2(s[4 * 33], s[5 * 33]); o.w = pk2(s[6 * 33], s[7 * 33]);
        *(u32x4*)(WT + (size_t)(drow0 + n) * K + k0 + 8 * c) = o; }
    asm volatile("s_waitcnt lgkmcnt(0)" ::: "memory");
}

__device__ __forceinline__ void prologue(KArgs pa, LAS unsigned char* lds, int tid, int lane, int wave) {
    const int G = gridDim.x, bx = blockIdx.x;
    float* modv = (float*)(pa->ws + WS_MOD);
    if (bx == 0) { float* rt = (float*)(pa->ws + WS_ROPE);
        if (tid < 36) __hip_atomic_store((unsigned*)(pa->ws + WS_CTR) + 64 * tid, 0u, __ATOMIC_RELAXED, __HIP_MEMORY_SCOPE_AGENT);
        for (int i = tid; i < 3456  ; i += NTHR) __hip_atomic_store((unsigned*)(pa->ws + WS_BAR) + i, 0u, __ATOMIC_RELAXED, __HIP_MEMORY_SCOPE_AGENT);
        for (int i = tid; i < 1024; i += NTHR) { const int pos = i >> 4, f = i & 15; const float inv = exp2f(-(float)f * (13.287712379549449f / 16.f)); const float ang = (float)pos * inv;
            rt[i] = cosf(ang); rt[1024 + i] = sinf(ang); } }
    if (bx < 288) {
        LAS float* sc = (LAS float*)lds; LAS float* part = (LAS float*)(lds + 36864);
        for (int i = tid; i < 9 * DM; i += NTHR) { const int row = i >> 10, k = i & 1023; const float v = row < 8 ? pa->in[1][row * DM + k] : pa->in[3][k]; sc[i] = silu_f(v); }
        __syncthreads();
        for (int unit = bx; unit < 288; unit += G) {
            const int l = unit / 144, cg64 = unit % 144, col = cg64 * 64 + lane;
            const float* w = pa->in[4] + (size_t)l * DM * NMODC + col;
            float acc[9];
#pragma unroll
            for (int r = 0; r < 9; ++r) acc[r] = 0.f;
            for (int k = wave * 128; k < wave * 128 + 128; k += 4) {
                const float w0 = __builtin_nontemporal_load(w + (size_t)k * NMODC), w1 = __builtin_nontemporal_load(w + (size_t)(k + 1) * NMODC), w2 = __builtin_nontemporal_load(w + (size_t)(k + 2) * NMODC), w3 = __builtin_nontemporal_load(w + (size_t)(k + 3) * NMODC);
#pragma unroll
                for (int r = 0; r < 9; ++r) { const f32x4 s = *(const LAS f32x4*)(sc + r * DM + k); acc[r] += s[0] * w0 + s[1] * w1 + s[2] * w2 + s[3] * w3; }
            }
#pragma unroll
            for (int r = 0; r < 9; ++r) part[(wave * 9 + r) * 64 + lane] = acc[r];
            __syncthreads();
            for (int i = tid; i < 576; i += NTHR) { const int r = i >> 6, cl = i & 63; float s = 0.f;
#pragma unroll
                for (int w8 = 0; w8 < 8; ++w8) s += part[(w8 * 9 + r) * 64 + cl];
                modv[((size_t)l * 9 + r) * NMODC + cg64 * 64 + cl] = s + pa->in[5][l * NMODC + cg64 * 64 + cl]; }
            __syncthreads();
        }
    }
    LAS float* scr = (LAS float*)(lds + 65536 + wave * 8704);
    const int gw = bx * NWAVES + wave, NGW = G * NWAVES;
    constexpr int I_GU = 16 * 176, I_DN = 44 * 32, I_IN = 16 * 168, I_OA = 6 * 32, I_OC = 4 * 32, I_WO = 16 * 32, I_L = 2 * I_GU + 2 * I_DN + I_IN + 2 * I_OA + I_OC + I_WO;
    for (int it = gw; it < 2 * I_L; it += NGW) {
        const int l = it / I_L; int r = it - l * I_L;
        bf16* wl = (bf16*)(pa->ws + WS_W) + (size_t)l * WL_ELEMS;
        if (r < 2 * (I_GU + I_DN)) {
            const int f = r / (I_GU + I_DN); r -= f * (I_GU + I_DN);
            if (r < I_GU) { const int kb = r / 176, nb = r % 176; transpose_item(pa->in[7 + 2 * f] + (size_t)l * DM * 2 * DFF, DM, 2 * DFF, wl + (f ? WO_GU2 : WO_GU1), 64 * kb, 32 * nb, gu_row(32 * nb), scr, lane); }
            else { r -= I_GU; const int kb = r / 32, nb = r % 32; transpose_item(pa->in[8 + 2 * f] + (size_t)l * DFF * DM, DFF, DM, wl + (f ? WO_DN2 : WO_DN1), 64 * kb, 32 * nb, 32 * nb, scr, lane); }
            continue;
        }
        r -= 2 * (I_GU + I_DN);
        if (r < I_IN) { const int kb = r / 168, nb = r % 168; transpose_item(pa->in[11] + (size_t)l * DM * IN_DIM, DM, IN_DIM, wl + WO_IN, 64 * kb, 32 * nb, in_row(32 * nb), scr, lane); continue; }
        r -= I_IN;
        if (r < I_OA) { const int kb = r / 32, nb = r % 32; transpose_item(pa->in[19] + (size_t)l * 384 * DM, 384, DM, wl + WO_OA, 64 * kb, 32 * nb, 32 * nb, scr, lane); continue; }
        r -= I_OA;
        if (r < I_OA) { const int kb = r / 32, nb = r % 32; transpose_item(pa->in[20] + (size_t)l * 384 * DM, 384, DM, wl + WO_OB, 64 * kb, 32 * nb, 32 * nb, scr, lane); continue; }
        r -= I_OA;
        if (r < I_OC) { const int kb = r / 32, nb = r % 32; transpose_item(pa->in[21] + (size_t)l * 256 * DM, 256, DM, wl + WO_OC, 64 * kb, 32 * nb, 32 * nb, scr, lane); continue; }
        r -= I_OC;
        { const int kb = r / 32, nb = r % 32; transpose_item(pa->in[22] + (size_t)l * DM * DM, DM, DM, wl + WO_WO, 64 * kb, 32 * nb, 32 * nb, scr, lane); }
    }
}

__device__ __forceinline__ void row_load(f32x4 (&v)[4], const void* base, size_t row, bool f32src, int lane) {
    if (f32src) {
#pragma unroll
        for (int j = 0; j < 4; ++j) v[j] = *((const f32x4*)((const float*)base + row * DM) + lane + 64 * j);
    } else {
#pragma unroll
        for (int j = 0; j < 4; ++j) { const u32x2 w = *((const u32x2*)((const bf16*)base + row * DM) + lane + 64 * j); v[j] = pg8::bflo(w.x, w.y); }
    }
}
__device__ __forceinline__ void ctx_reduce(f32x4 (&v)[4], int rc, const float* part, const float* pgate, float coef, bf16* xc_out, int lane) {
#pragma unroll
    for (int j = 0; j < 4; ++j) {
        f32x4 s = *((const f32x4*)(part + (size_t)rc * DM) + lane + 64 * j);
#pragma unroll
        for (int sl = 1; sl < 4; ++sl) s = s + *((const f32x4*)(part + ((size_t)sl * MCTX + rc) * DM) + lane + 64 * j);
        v[j] = v[j] + *((const f32x4*)pgate + lane + 64 * j) * coef * s;
        ((unsigned long long*)(xc_out + (size_t)rc * DM))[lane + 64 * j] = (unsigned long long)pk2(v[j][0], v[j][1]) | ((unsigned long long)pk2(v[j][2], v[j][3]) << 32);
    }
}
__device__ __forceinline__ void norm_phase(const void* xl, const void* xc, bool f32src, bool f32ctx, const float* g, const float* modl, int shift_q, int scale_q, bf16* H, int nrows,
                                           const float* part, const float* pgate, float coef, bf16* xc_out, int lane, int wave) {
    const int gw = blockIdx.x * NWAVES + wave, NGW = gridDim.x * NWAVES;
    f32x4 gv[4];
#pragma unroll
    for (int j = 0; j < 4; ++j) gv[j] = *((const f32x4*)g + lane + 64 * j);
    for (int r0 = gw; r0 < nrows; r0 += 2 * NGW) {
        const int r1 = r0 + NGW; const bool has1 = r1 < nrows; const int r1c = has1 ? r1 : r0;
        f32x4 v0[4], v1[4]; float s0 = 0.f, s1 = 0.f;
        row_load(v0, r0 < MLAT ? xl : xc, (size_t)(r0 < MLAT ? r0 : r0 - MLAT), r0 < MLAT ? f32src : f32ctx, lane);
        row_load(v1, r1c < MLAT ? xl : xc, (size_t)(r1c < MLAT ? r1c : r1c - MLAT), r1c < MLAT ? f32src : f32ctx, lane);
        if (part && r0 >= MLAT) ctx_reduce(v0, r0 - MLAT, part, pgate, coef, xc_out, lane);
        if (part && has1 && r1 >= MLAT) ctx_reduce(v1, r1 - MLAT, part, pgate, coef, xc_out, lane);
#pragma unroll
        for (int j = 0; j < 4; ++j) { s0 += (v0[j][0] * v0[j][0] + v0[j][1] * v0[j][1]) + (v0[j][2] * v0[j][2] + v0[j][3] * v0[j][3]); s1 += (v1[j][0] * v1[j][0] + v1[j][1] * v1[j][1]) + (v1[j][2] * v1[j][2] + v1[j][3] * v1[j][3]); }
        const float rstd0 = 1.f / sqrtf(wave_sum(s0) * (1.f / DM) + RMS_EPS), rstd1 = 1.f / sqrtf(wave_sum(s1) * (1.f / DM) + RMS_EPS);
        const float* mv0 = modl + (r0 < MLAT ? (r0 >> 12) : 8) * NMODC; const float* mv1 = modl + (r1c < MLAT ? (r1c >> 12) : 8) * NMODC;
        unsigned long long* o0 = (unsigned long long*)(H + (size_t)r0 * DM) + lane; unsigned long long* o1 = (unsigned long long*)(H + (size_t)r1c * DM) + lane;
#pragma unroll
        for (int j = 0; j < 4; ++j) {
            const f32x4 sh0 = *((const f32x4*)(mv0 + shift_q * DM) + lane + 64 * j), sc0 = *((const f32x4*)(mv0 + scale_q * DM) + lane + 64 * j);
            const f32x4 y0 = v0[j] * rstd0 * gv[j] * (sc0 + 1.f) + sh0;
            o0[64 * j] = (unsigned long long)pk2(y0[0], y0[1]) | ((unsigned long long)pk2(y0[2], y0[3]) << 32);
            if (has1) {
                const f32x4 sh1 = *((const f32x4*)(mv1 + shift_q * DM) + lane + 64 * j), sc1 = *((const f32x4*)(mv1 + scale_q * DM) + lane + 64 * j);
                const f32x4 y1 = v1[j] * rstd1 * gv[j] * (sc1 + 1.f) + sh1;
                o1[64 * j] = (unsigned long long)pk2(y1[0], y1[1]) | ((unsigned long long)pk2(y1[2], y1[3]) << 32);
            }
        }
    }
}
__device__ __forceinline__ void final_norm(const bf16* x, float* out, const float* g, int lane, int wave) {
    const int gw = blockIdx.x * NWAVES + wave, NGW = gridDim.x * NWAVES;
    f32x4 gv[4];
#pragma unroll
    for (int j = 0; j < 4; ++j) gv[j] = *((const f32x4*)g + lane + 64 * j);
    for (int r = gw; r < MLAT; r += NGW) {
        f32x4 v[4]; float s = 0.f;
        row_load(v, x, (size_t)r, false, lane);
#pragma unroll
        for (int j = 0; j < 4; ++j) s += (v[j][0] * v[j][0] + v[j][1] * v[j][1]) + (v[j][2] * v[j][2] + v[j][3] * v[j][3]);
        const float rstd = 1.f / sqrtf(wave_sum(s) * (1.f / DM) + RMS_EPS);
        f32x4* orow = (f32x4*)(out + (size_t)r * DM) + lane;
#pragma unroll
        for (int j = 0; j < 4; ++j) __builtin_nontemporal_store(v[j] * rstd * gv[j], orow + 64 * j);
    }
}

#define MFMA16(a, b, c) __builtin_amdgcn_mfma_f32_16x16x32_bf16((a), (b), (c), 0, 0, 0)
#define AINL __attribute__((always_inline))
template <int NQ> struct AQ { bf16x8 qf[NQ][2]; float m[NQ], l[NQ]; f32x4 o[NQ][4]; };
struct KF { bf16x8 ka[2], kb[2]; };
struct VF { bf16x8 v[4]; };
__device__ __forceinline__ void k_load(KF& d, const bf16* kpa, const bf16* kpb) {
    d.ka[0] = *(const bf16x8*)kpa; d.ka[1] = *(const bf16x8*)(kpa + 32); d.kb[0] = *(const bf16x8*)kpb; d.kb[1] = *(const bf16x8*)(kpb + 32);
}
__device__ __forceinline__ void v_load(VF& d, const bf16* va, const bf16* vb) {
#pragma unroll
    for (int nb = 0; nb < 4; ++nb) { const u32x2 x = *(const u32x2*)(va + (size_t)nb * 16 * MALL), y = *(const u32x2*)(vb + (size_t)nb * 16 * MALL);
        u32x4 vw; vw.x = x.x; vw.y = x.y; vw.z = y.x; vw.w = y.y; d.v[nb] = __builtin_bit_cast(bf16x8, vw); }
}
template <int NQ> __device__ __forceinline__ void aq_init(AQ<NQ>& A) {
#pragma unroll
    for (int q = 0; q < NQ; ++q) { A.m[q] = NEGB; A.l[q] = 0.f;
#pragma unroll
        for (int nb = 0; nb < 4; ++nb) A.o[q][nb] = (f32x4){0.f, 0.f, 0.f, 0.f}; }
}
template <int NQ, class G, class F> __device__ __forceinline__ void pair_compute(AQ<NQ>& A, const KF& c, const VF& cv, G&& act, F&& f) {
    bf16x8 pf[NQ];
#pragma unroll
    for (int q = 0; q < NQ; ++q) {
        if (!act(q)) continue;
        f32x4 sa = {0.f, 0.f, 0.f, 0.f}, sb = {0.f, 0.f, 0.f, 0.f};
        sa = MFMA16(c.ka[0], A.qf[q][0], sa); sa = MFMA16(c.ka[1], A.qf[q][1], sa);
        sb = MFMA16(c.kb[0], A.qf[q][0], sb); sb = MFMA16(c.kb[1], A.qf[q][1], sb);
        f(q, sa, sb);
        float mx = fmaxf(fmaxf(fmaxf(sa[0], sa[1]), fmaxf(sa[2], sa[3])), fmaxf(fmaxf(sb[0], sb[1]), fmaxf(sb[2], sb[3])));
        mx = fmaxf(mx, __shfl_xor(mx, 16)); mx = fmaxf(mx, __shfl_xor(mx, 32));
        const float mn = fmaxf(A.m[q], mx), sc = ex2(A.m[q] - mn);
        A.m[q] = mn;
#pragma unroll
        for (int nb = 0; nb < 4; ++nb) A.o[q][nb] = A.o[q][nb] * sc;
#pragma unroll
        for (int i = 0; i < 4; ++i) { sa[i] = ex2(sa[i] - mn); sb[i] = ex2(sb[i] - mn); }
        A.l[q] = A.l[q] * sc + ((sa[0] + sa[1]) + (sa[2] + sa[3])) + ((sb[0] + sb[1]) + (sb[2] + sb[3]));
        u32x4 pw; pw.x = pk2(sa[0], sa[1]); pw.y = pk2(sa[2], sa[3]); pw.z = pk2(sb[0], sb[1]); pw.w = pk2(sb[2], sb[3]);
        pf[q] = __builtin_bit_cast(bf16x8, pw);
    }
#pragma unroll
    for (int q = 0; q < NQ; ++q) {
        if (!act(q)) continue;
#pragma unroll
        for (int nb = 0; nb < 4; ++nb) A.o[q][nb] = MFMA16(cv.v[nb], pf[q], A.o[q][nb]);
    }
}
template <class LD, class ST> __device__ __forceinline__ void pingpong(int n, LD&& ld, ST&& st) {
    KF k0, k1;
    ld(k0, 0);
    int t = 0;
#pragma unroll 1
    for (; t + 1 < n; t += 2) {
        ld(k1, t + 1);
        st(k0, t);
        ld(k0, min(t + 2, n - 1));
        st(k1, t + 1);
    }
    if (t < n) st(k0, t);
}
template <int NQ> __device__ __forceinline__ void ctx_chunk(AQ<NQ>& A, const bf16* kp, int ldk, const bf16* vp) {
    pingpong(8,
        [&](KF& kf, int t) AINL { k_load(kf, kp + (size_t)(32 * t) * ldk, kp + (size_t)(32 * t + 16) * ldk); },
        [&](const KF& kf, int t) AINL { VF vf; v_load(vf, vp + 32 * t, vp + 32 * t + 16); pair_compute<NQ>(A, kf, vf, [](int) AINL { return true; }, [](int, f32x4&, f32x4&) AINL {}); });
}
__device__ __forceinline__ void attn_store1(const f32x4 (&o)[4], float l, bf16* yp  ) {
    l += __shfl_xor(l, 16); l += __shfl_xor(l, 32);
    const float inv = 1.f / l;
#pragma unroll
    for (int nb = 0; nb < 4; ++nb) { u32x2 w; w.x = pk2(o[nb][0] * inv, o[nb][1] * inv); w.y = pk2(o[nb][2] * inv, o[nb][3] * inv); *(u32x2*)(yp + 16 * nb) = w; }
}
template <int NQ> __device__ __forceinline__ void sink_fold(AQ<NQ>& A, const float* sink, int h0, int fq) {
#pragma unroll
    for (int q = 0; q < NQ; ++q) { const float sk = sink[h0 + q] * LOG2E, mn = fmaxf(A.m[q], sk), sc = ex2(A.m[q] - mn); A.l[q] *= sc;
#pragma unroll
        for (int nb = 0; nb < 4; ++nb) A.o[q][nb] = A.o[q][nb] * sc;
        if (fq == 0) A.l[q] += ex2(sk - mn); }
}

struct AttnBufs { const bf16 *QA, *KA, *QB, *KB, *VT; bf16 *YA, *YB; };

__device__ __forceinline__ void na_unit(const AttnBufs& T, const LAS float* btab, int b, int h, int j, int rp, int fr, int fq) {
    const int hoff = h * 64, r0 = 2 * rp;
    AQ<2> A; aq_init<2>(A);
#pragma unroll
    for (int q = 0; q < 2; ++q) { const bf16* qp = T.QA + (size_t)(b * SEQ + (r0 + q) * 64 + 16 * j + fr) * 384 + hoff + 8 * fq; A.qf[q][0] = *(const bf16x8*)qp; A.qf[q][1] = *(const bf16x8*)(qp + 32); }
    const int ka0 = min(max(r0 - 4, 0), 56), kb0 = min(max(r0 - 3, 0), 56), nrow = kb0 - ka0 + 8, c0 = min(max(16 * j - 8, 0), 32);
    const int c = 16 * j + fr, w0 = min(max(c - 8, 0), 48);
    int dxo[8];
#pragma unroll
    for (int e = 0; e < 8; ++e) { const int kc = c0 + 16 * (e >> 2) + 4 * fq + (e & 3); const bool in = (kc >= w0) && (kc < w0 + 16); dxo[e] = in ? min(max(kc - c + 15, 0), 30) : 31; }
    {
        const int tk0 = b * SEQ + ka0 * 64 + c0;
        const bf16* kp = T.KA + (size_t)(tk0 + fr) * 384 + hoff + 8 * fq;
        const bf16* vp = T.VT + (size_t)(hoff + fr) * MALL + tk0 + 4 * fq;
        const LAS float* bh = btab + h * (15 * 32);
        pingpong(nrow,
            [&](KF& kf, int t) AINL { k_load(kf, kp + (size_t)(t * 64) * 384, kp + (size_t)(t * 64 + 16) * 384); },
            [&](const KF& kf, int t) AINL {
            VF vf; v_load(vf, vp + t * 64, vp + t * 64 + 16);
            const int ky = ka0 + t;
            pair_compute<2>(A, kf, vf,
                [&](int q) AINL { const int k0 = q ? kb0 : ka0; return (ky >= k0) && (ky < k0 + 8); },
                [&](int q, f32x4& sa, f32x4& sb) AINL {
                    const LAS float* rp_ = bh + (ky - (r0 + q) + 7) * 32;
#pragma unroll
                    for (int i = 0; i < 4; ++i) { sa[i] += rp_[dxo[i]]; sb[i] += rp_[dxo[4 + i]]; } }); });
    }
    ctx_chunk<2>(A, T.KA + (size_t)(MLAT + b * CTXL + fr) * 384 + hoff + 8 * fq, 384, T.VT + (size_t)(hoff + fr) * MALL + MLAT + b * CTXL + 4 * fq);
#pragma unroll
    for (int q = 0; q < 2; ++q) attn_store1(A.o[q], A.l[q], T.YA + (size_t)(b * SEQ + (r0 + q) * 64 + 16 * j + fr) * 384 + hoff + 4 * fq);
}
__device__ __forceinline__ void sw_unit(const AttnBufs& T, const float* sink, int b, int kvh, int qb, int fr, int fq) {
    const int q0 = 16 * qb, tq0 = b * SEQ + q0, khoff = kvh * 64, h0 = 3 * kvh;
    AQ<3> A; aq_init<3>(A);
#pragma unroll
    for (int q = 0; q < 3; ++q) { const bf16* qp = T.QB + (size_t)(tq0 + fr) * 384 + (h0 + q) * 64 + 8 * fq; A.qf[q][0] = *(const bf16x8*)qp; A.qf[q][1] = *(const bf16x8*)(qp + 32); }
    {
        const int tq = q0 + fr;
        const bool edge = (q0 < 128) || (q0 + 160 > SEQ);
        const bf16* kbase = T.KB + (size_t)(b * SEQ) * 128 + khoff + 8 * fq;
        const bf16* vrow = T.VT + (size_t)(384 + khoff + fr) * MALL + b * SEQ;
#define SW_KLOAD(dst, t) do { const int ka_ = q0 - 128 + 32 * (t); \
            k_load(dst, kbase + (size_t)min(max(ka_ + fr, 0), SEQ - 1) * 128, kbase + (size_t)min(max(ka_ + 16 + fr, 0), SEQ - 1) * 128); } while (0)
#define SW_VLOAD(dst, t) do { const int ka_ = q0 - 128 + 32 * (t); \
            v_load(dst, vrow + min(max(ka_ + 4 * fq, 0), SEQ - 4), vrow + min(max(ka_ + 16 + 4 * fq, 0), SEQ - 4)); } while (0)
        pingpong(9,
            [&](KF& kf, int t) AINL { SW_KLOAD(kf, t); },
            [&](const KF& kf, int t) AINL {
            VF vf; SW_VLOAD(vf, t);
            const int kt0 = q0 - 128 + 32 * t;
            const bool need = edge || (t == 0) || (t == 8);
            pair_compute<3>(A, kf, vf, [](int) AINL { return true; }, [&](int, f32x4& sa, f32x4& sb) AINL {
                if (need) {
#pragma unroll
                    for (int i = 0; i < 4; ++i) {
                        { const int tk = kt0 + 4 * fq + i, d = tq - tk; const bool ok = (d <= 128) && (d >= -128) && (tk >= 0) && (tk < SEQ); sa[i] = ok ? sa[i] : NEGB; }
                        { const int tk = kt0 + 16 + 4 * fq + i, d = tq - tk; const bool ok = (d <= 128) && (d >= -128) && (tk >= 0) && (tk < SEQ); sb[i] = ok ? sb[i] : NEGB; }
                    } } }); });
#undef SW_KLOAD
#undef SW_VLOAD
    }
    ctx_chunk<3>(A, T.KB + (size_t)(MLAT + b * CTXL + fr) * 128 + khoff + 8 * fq, 128, T.VT + (size_t)(384 + khoff + fr) * MALL + MLAT + b * CTXL + 4 * fq);
    sink_fold<3>(A, sink, h0, fq);
#pragma unroll
    for (int q = 0; q < 3; ++q) attn_store1(A.o[q], A.l[q], T.YB + (size_t)(tq0 + fr) * 384 + (h0 + q) * 64 + 4 * fq);
}
__device__ __forceinline__ void ctxa_unit(const AttnBufs& T, int b, int h, int qb, int fr, int fq) {
    const int tq0 = MLAT + b * CTXL + 16 * qb, hoff = h * 64;
    AQ<1> A; aq_init<1>(A);
    { const bf16* qp = T.QA + (size_t)(tq0 + fr) * 384 + hoff + 8 * fq; A.qf[0][0] = *(const bf16x8*)qp; A.qf[0][1] = *(const bf16x8*)(qp + 32); }
    ctx_chunk<1>(A, T.KA + (size_t)(MLAT + b * CTXL + fr) * 384 + hoff + 8 * fq, 384, T.VT + (size_t)(hoff + fr) * MALL + MLAT + b * CTXL + 4 * fq);
    attn_store1(A.o[0], A.l[0], T.YA + (size_t)(tq0 + fr) * 384 + hoff + 4 * fq);
}
__device__ __forceinline__ void ctxb_unit(const AttnBufs& T, const float* sink, int b, int kvh, int qb, int fr, int fq) {
    const int tq0 = MLAT + b * CTXL + 16 * qb, khoff = kvh * 64, h0 = 3 * kvh;
    AQ<3> A; aq_init<3>(A);
#pragma unroll
    for (int q = 0; q < 3; ++q) { const bf16* qp = T.QB + (size_t)(tq0 + fr) * 384 + (h0 + q) * 64 + 8 * fq; A.qf[q][0] = *(const bf16x8*)qp; A.qf[q][1] = *(const bf16x8*)(qp + 32); }
    ctx_chunk<3>(A, T.KB + (size_t)(MLAT + b * CTXL + fr) * 128 + khoff + 8 * fq, 128, T.VT + (size_t)(384 + khoff + fr) * MALL + MLAT + b * CTXL + 4 * fq);
    sink_fold<3>(A, sink, h0, fq);
#pragma unroll
    for (int q = 0; q < 3; ++q) attn_store1(A.o[q], A.l[q], T.YB + (size_t)(tq0 + fr) * 384 + (h0 + q) * 64 + 4 * fq);
}
constexpr int LWL = 0, LBT = 64512, LK = 76800, SROW = 144, SBUF = 64 * SROW, LBU = LK + 6 * SBUF;
struct Stage { u32x4 k, v; };
__device__ __forceinline__ void stage_load(Stage& s, const bf16* kg, const bf16* vg) { s.k = *(const u32x4*)kg; s.v = *(const u32x4*)vg; }
__device__ __forceinline__ void stage_write(LAS unsigned char* buf, const Stage& s, int tid) { const int o = (tid >> 3) * SROW + (tid & 7) * 16; *(LAS u32x4*)(buf + o) = s.k; *(LAS u32x4*)(buf + SBUF + o) = s.v; }
__device__ __forceinline__ void lds_kf(KF& d, const LAS unsigned char* kb, int tokoff, int fr, int fq) {
    const LAS unsigned char* p = kb + (tokoff + fr) * SROW + fq * 16;
    d.ka[0] = *(const LAS bf16x8*)p; d.ka[1] = *(const LAS bf16x8*)(p + 64); d.kb[0] = *(const LAS bf16x8*)(p + 16 * SROW); d.kb[1] = *(const LAS bf16x8*)(p + 16 * SROW + 64);
}
__device__ __forceinline__ void lds_vf(VF& d, const LAS unsigned char* vb, int tokoff, int fr, int fq) {
#pragma unroll
    for (int nb = 0; nb < 4; ++nb) { const LAS unsigned char* p = vb + (fr + 16 * nb) * SROW + (tokoff + 4 * fq) * 2; const u32x2 x = *(const LAS u32x2*)p, y = *(const LAS u32x2*)(p + 32);
        u32x4 vw; vw.x = x.x; vw.y = x.y; vw.z = y.x; vw.w = y.y; d.v[nb] = __builtin_bit_cast(bf16x8, vw); }
}
template <int NQ, class F> __device__ __forceinline__ void set_step(AQ<NQ>& A, const int q, const KF& c, const VF& cv, F&& f) {
    f32x4 sa = {0.f, 0.f, 0.f, 0.f}, sb = {0.f, 0.f, 0.f, 0.f};
    sa = MFMA16(c.ka[0], A.qf[q][0], sa); sa = MFMA16(c.ka[1], A.qf[q][1], sa);
    sb = MFMA16(c.kb[0], A.qf[q][0], sb); sb = MFMA16(c.kb[1], A.qf[q][1], sb);
    f(sa, sb);
    float mx = fmaxf(fmaxf(fmaxf(sa[0], sa[1]), fmaxf(sa[2], sa[3])), fmaxf(fmaxf(sb[0], sb[1]), fmaxf(sb[2], sb[3])));
    mx = fmaxf(mx, __shfl_xor(mx, 16)); mx = fmaxf(mx, __shfl_xor(mx, 32));
    const float mn = fmaxf(A.m[q], mx), sc = ex2(A.m[q] - mn);
    A.m[q] = mn;
#pragma unroll
    for (int nb = 0; nb < 4; ++nb) A.o[q][nb] = A.o[q][nb] * sc;
#pragma unroll
    for (int i = 0; i < 4; ++i) { sa[i] = ex2(sa[i] - mn); sb[i] = ex2(sb[i] - mn); }
    A.l[q] = A.l[q] * sc + ((sa[0] + sa[1]) + (sa[2] + sa[3])) + ((sb[0] + sb[1]) + (sb[2] + sb[3]));
    u32x4 pw; pw.x = pk2(sa[0], sa[1]); pw.y = pk2(sa[2], sa[3]); pw.z = pk2(sb[0], sb[1]); pw.w = pk2(sb[2], sb[3]);
    const bf16x8 pf = __builtin_bit_cast(bf16x8, pw);
#pragma unroll
    for (int nb = 0; nb < 4; ++nb) A.o[q][nb] = MFMA16(cv.v[nb], pf, A.o[q][nb]);
}
template <class SRC, class CMP> __device__ __forceinline__ void chunk_pipeline(LAS unsigned char* lds, int n, int tid, SRC&& src, CMP&& cmp) {
    Stage sA, sB; const bf16* kg; const bf16* vg;
    { Stage s0; src(0, kg, vg); stage_load(s0, kg, vg);
      if (n > 1) { src(1, kg, vg); stage_load(sA, kg, vg); }
      if (n > 2) { src(2, kg, vg); stage_load(sB, kg, vg); }
      stage_write(lds + LK, s0, tid); }
    __syncthreads();
    int i = 0, bi = 0;
#pragma unroll 1
    for (;;) {
        { LAS unsigned char* cur = lds + LK + bi * 2 * SBUF; const int bn = bi == 2 ? 0 : bi + 1;
          cmp(i, cur, cur + SBUF);
          if (i + 1 < n) stage_write(lds + LK + bn * 2 * SBUF, sA, tid);
          if (i + 3 < n) { src(i + 3, kg, vg); stage_load(sA, kg, vg); }
          __syncthreads(); ++i; bi = bn; if (i >= n) break; }
        { LAS unsigned char* cur = lds + LK + bi * 2 * SBUF; const int bn = bi == 2 ? 0 : bi + 1;
          cmp(i, cur, cur + SBUF);
          if (i + 1 < n) stage_write(lds + LK + bn * 2 * SBUF, sB, tid);
          if (i + 3 < n) { src(i + 3, kg, vg); stage_load(sB, kg, vg); }
          __syncthreads(); ++i; bi = bn; if (i >= n) break; }
    }
}
__device__ __forceinline__ void sw_block(const AttnBufs& T, const float* sink, LAS unsigned char* lds, int b, int kvh, int qblk, int tid, int wave, int fr, int fq) {
    const int q0 = 128 * qblk, wq0 = q0 + 16 * wave, tq0 = b * SEQ + wq0, khoff = kvh * 64, h0 = 3 * kvh;
    AQ<3> A; aq_init<3>(A);
#pragma unroll
    for (int q = 0; q < 3; ++q) { const bf16* qp = T.QB + (size_t)(tq0 + fr) * 384 + (h0 + q) * 64 + 8 * fq; A.qf[q][0] = *(const bf16x8*)qp; A.qf[q][1] = *(const bf16x8*)(qp + 32); }
    const int c_lo = q0 < 128 ? 2 : 0, c_hi = q0 + 256 > SEQ ? 4 : 6, nl = c_hi - c_lo;
    const int srow = tid >> 3, sseg = (tid & 7) * 8;
    chunk_pipeline(lds, nl + 4, tid,
        [&](int i, const bf16*& kg, const bf16*& vg) AINL {
            const int t0 = i < nl ? b * SEQ + q0 - 128 + 64 * (c_lo + i) : MLAT + b * CTXL + 64 * (i - nl);
            kg = T.KB + (size_t)(t0 + srow) * 128 + khoff + sseg; vg = T.VT + (size_t)(384 + khoff + srow) * MALL + t0 + sseg; },
        [&](int i, const LAS unsigned char* kb, const LAS unsigned char* vb) AINL {
            const bool loc = i < nl; const int t0 = q0 - 128 + 64 * (c_lo + i);
#pragma unroll
            for (int p = 0; p < 2; ++p) {
                const int ps = t0 + 32 * p;
                if (loc && !((ps + 31 >= wq0 - 128) && (ps <= wq0 + 15 + 128))) continue;
                const bool need = loc && !((ps >= wq0 + 15 - 128) && (ps + 31 <= wq0 + 128));
                KF kf; VF vf; lds_kf(kf, kb, 32 * p, fr, fq); lds_vf(vf, vb, 32 * p, fr, fq);
#pragma unroll
                for (int q = 0; q < 3; ++q) set_step<3>(A, q, kf, vf, [&](f32x4& sa, f32x4& sb) AINL {
                    if (need) {
#pragma unroll
                        for (int e = 0; e < 4; ++e) { const int da = (wq0 + fr) - (ps + 4 * fq + e), db = da - 16; sa[e] = (da <= 128 && da >= -128) ? sa[e] : NEGB; sb[e] = (db <= 128 && db >= -128) ? sb[e] : NEGB; }
                    } });
            } });
    sink_fold<3>(A, sink, h0, fq);
#pragma unroll
    for (int q = 0; q < 3; ++q) attn_store1(A.o[q], A.l[q], T.YB + (size_t)(tq0 + fr) * 384 + (h0 + q) * 64 + 4 * fq);
}
__device__ __forceinline__ void na_block(const AttnBufs& T, const LAS float* btab, LAS unsigned char* lds, int b, int h, int g, int tid, int wave, int fr, int fq) {
    const int hoff = h * 64, r = 4 * g + (wave >> 1), jb = 2 * (wave & 1), tq0 = b * SEQ + r * 64 + 16 * jb;
    AQ<2> A; aq_init<2>(A);
    unsigned dxp[2][2];
    int c0s[2];
#pragma unroll
    for (int jj = 0; jj < 2; ++jj) {
        const int j = jb + jj;
        const bf16* qp = T.QA + (size_t)(tq0 + 16 * jj + fr) * 384 + hoff + 8 * fq; A.qf[jj][0] = *(const bf16x8*)qp; A.qf[jj][1] = *(const bf16x8*)(qp + 32);
        const int c = 16 * j + fr, w0 = min(max(c - 8, 0), 48), c0 = min(max(16 * j - 8, 0), 32);
        c0s[jj] = c0;
#pragma unroll
        for (int x = 0; x < 2; ++x) { unsigned w = 0;
#pragma unroll
            for (int e = 0; e < 4; ++e) { const int kc = c0 + 16 * x + 4 * fq + e; const bool in = (kc >= w0) && (kc < w0 + 16); const int dx = in ? min(max(kc - c + 15, 0), 30) : 31; w |= (unsigned)(4 * dx) << (8 * e); }
            dxp[jj][x] = w; }
    }
    const int kr0 = min(max(r - 4, 0), 56), ku0 = min(max(4 * g - 4, 0), 56), nl = min(max(4 * g - 1, 0), 56) + 8 - ku0;
    const int srow = tid >> 3, sseg = (tid & 7) * 8;
    const LAS unsigned char* bh = (const LAS unsigned char*)(btab + h * (15 * 32));
    chunk_pipeline(lds, nl + 4, tid,
        [&](int i, const bf16*& kg, const bf16*& vg) AINL {
            const int t0 = i < nl ? b * SEQ + (ku0 + i) * 64 : MLAT + b * CTXL + 64 * (i - nl);
            kg = T.KA + (size_t)(t0 + srow) * 384 + hoff + sseg; vg = T.VT + (size_t)(hoff + srow) * MALL + t0 + sseg; },
        [&](int i, const LAS unsigned char* kb, const LAS unsigned char* vb) AINL {
            if (i < nl) {
                const int ky = ku0 + i;
                if ((ky >= kr0) && (ky < kr0 + 8)) {
                    const LAS unsigned char* rp_ = bh + (ky - r + 7) * 128;
#pragma unroll
                    for (int jj = 0; jj < 2; ++jj) {
                        KF kf; VF vf; lds_kf(kf, kb, c0s[jj], fr, fq); lds_vf(vf, vb, c0s[jj], fr, fq);
                        set_step<2>(A, jj, kf, vf, [&](f32x4& sa, f32x4& sb) AINL {
#pragma unroll
                            for (int e = 0; e < 4; ++e) { sa[e] += *(const LAS float*)(rp_ + ((dxp[jj][0] >> (8 * e)) & 0xffu)); sb[e] += *(const LAS float*)(rp_ + ((dxp[jj][1] >> (8 * e)) & 0xffu)); } });
                    }
                }
            } else {
#pragma unroll
                for (int p = 0; p < 2; ++p) { KF kf; VF vf; lds_kf(kf, kb, 32 * p, fr, fq); lds_vf(vf, vb, 32 * p, fr, fq);
#pragma unroll
                    for (int jj = 0; jj < 2; ++jj) set_step<2>(A, jj, kf, vf, [](f32x4&, f32x4&) AINL {}); }
            } });
#pragma unroll
    for (int jj = 0; jj < 2; ++jj) attn_store1(A.o[jj], A.l[jj], T.YA + (size_t)(tq0 + 16 * jj + fr) * 384 + hoff + 4 * fq);
}

__device__ __forceinline__ void conv_unit(const bf16* HG, bf16* YC, const LAS float* wl, const float* dwb, const float* lng, const float* lnb, int tok0, int lo, int hi, int lane) {
    const f32x4 bias = *((const f32x4*)dwb + lane);
    f32x4 acc[16];
#pragma unroll
    for (int t = 0; t < 16; ++t) acc[t] = bias;
#pragma unroll 1
    for (int ig = 0; ig < 6; ++ig) {
        u32x2 hv[8];
#pragma unroll
        for (int k = 0; k < 8; ++k) { const int r = tok0 - 15 + 8 * ig + k; hv[k] = (u32x2){0u, 0u}; if (r >= lo && r < hi) hv[k] = *(const u32x2*)(HG + (size_t)r * 256 + 4 * lane); }
#pragma unroll
        for (int k = 0; k < 8; ++k) {
            const f32x4 h = pg8::bflo(hv[k].x, hv[k].y);
            const LAS float* wp = wl + (8 * ig + k + 15) * 256 + 4 * lane;
#pragma unroll
            for (int t = 0; t < 16; ++t) acc[t] = acc[t] + h * *(const LAS f32x4*)(wp - t * 256);
        }
    }
    const f32x4 g = *((const f32x4*)lng + lane), be = *((const f32x4*)lnb + lane);
#pragma unroll
    for (int t = 0; t < 16; ++t) {
        const f32x4 v = acc[t];
        const float mu = wave_sum((v[0] + v[1]) + (v[2] + v[3])) * (1.f / 256.f);
        const f32x4 d = v - mu;
        const float var = wave_sum((d[0] * d[0] + d[1] * d[1]) + (d[2] * d[2] + d[3] * d[3])) * (1.f / 256.f);
        const float rstd = 1.f / sqrtf(var + RMS_EPS);
        const f32x4 y = d * rstd * g + be;
        u32x2 o; o.x = pk2(silu_f(y[0]), silu_f(y[1])); o.y = pk2(silu_f(y[2]), silu_f(y[3]));
        *(u32x2*)(YC + (size_t)(tok0 + t) * 256 + 4 * lane) = o;
    }
}

template <int rep> __device__ __forceinline__ void mixer_phase(KArgs pa, LAS unsigned char* lds, int l, int tid, int lane, int wave) {
    unsigned char* R = pa->ws + WS_R;
    AttnBufs T; T.QA = (const bf16*)(R + R_QA); T.KA = (const bf16*)(R + R_KA); T.QB = (const bf16*)(R + R_QB); T.KB = (const bf16*)(R + R_KB); T.VT = (const bf16*)(R + R_VT);
    T.YA = (bf16*)(R + R_YA); T.YB = (bf16*)(R + R_YB);
    const bf16* HG = (const bf16*)(R + R_HG); bf16* YC = (bf16*)(R + R_YC);
    LAS float* wl = (LAS float*)lds;
    for (int i = tid; i < 63 * 256; i += NTHR) { const int w = (i >> 8) - 15; wl[i] = (w >= 0 && w < 31) ? pa->in[15][l * 31 * 256 + w * 256 + (i & 255)] : 0.f; }
    LAS float* btab = (LAS float*)(lds + LBT);
    for (int i = tid; i < 6 * 15 * 32; i += NTHR) { const int dx = i & 31, hd = i >> 5; btab[i] = dx < 31 ? pa->in[13][l * (6 * 15 * 31) + hd * 31 + dx] * LOG2E : NEGB; }
    __syncthreads();
    const float* sink = pa->in[14] + l * 6;
    const float* dwb = pa->in[16] + l * 256; const float* lng = pa->in[17] + l * 256; const float* lnb = pa->in[18] + l * 256;
    {
        unsigned* ctrb = (unsigned*)(pa->ws + WS_CTR) + 64 * (32 + 2 * rep + l);
        volatile LAS int* bu = (volatile LAS int*)(lds + LBU);
        constexpr int BU_NA = NB * 6 * 16, BU_SW = NB * 2 * 32;
        for (;;) {
            if (tid == 0) *bu = (int)__hip_atomic_fetch_add(ctrb, 1u, __ATOMIC_RELAXED, __HIP_MEMORY_SCOPE_AGENT);
            __syncthreads();
            const int u = __builtin_amdgcn_readfirstlane(*bu);
            __syncthreads();
            if (u >= BU_NA + BU_SW) break;
            int fr = lane & 15, fq = lane >> 4; asm volatile("" : "+v"(fr), "+v"(fq));
            if (u < BU_NA) { const int g = u & 15, bh_ = u >> 4;
#ifndef NO_NAB
 na_block(T, btab, lds, bh_ / 6, bh_ % 6, g, tid, wave, fr, fq);
#endif
 }
            else { const int v = u - BU_NA, qblk = v & 31, bk = v >> 5;
#ifndef NO_SWB
 sw_block(T, sink, lds, bk >> 1, bk & 1, qblk, tid, wave, fr, fq);
#endif
 }
        }
    }
    constexpr int B_CVL = SEQ / 16, B_CXA = 6 * 16, B_CXB = 2 * 16, B_CVC = CTXL / 16;
    const int total = B_CVL + (l == 0 ? B_CXA + B_CXB + B_CVC : 0);
    unsigned* ctr0 = (unsigned*)(pa->ws + WS_CTR) + 64 * 8 * (2 * rep + l);
    const int x0 = (int)((unsigned)__builtin_amdgcn_s_getreg((3 << 11) | 20) & 7u);
    for (int xi = 0; xi < 8; ++xi) {
        const int b = (x0 + xi) & 7;
        unsigned* ctr = ctr0 + 64 * b;
        for (;;) {
            int u = 0; if (lane == 0) u = (int)__hip_atomic_fetch_add(ctr, 1u, __ATOMIC_RELAXED, __HIP_MEMORY_SCOPE_AGENT);
            u = __builtin_amdgcn_readfirstlane(u);
            if (u >= total) break;
            int r = u;
            int fr = lane & 15, fq = lane >> 4; asm volatile("" : "+v"(fr), "+v"(fq));
            if (r < B_CVL) { const int tok0 = b * SEQ + 16 * r; conv_unit(HG, YC, wl, dwb, lng, lnb, tok0, b * SEQ, b * SEQ + SEQ, lane); continue; }
            r -= B_CVL;
            if (r < B_CXA) { const int qb = r & 15, h = r >> 4; ctxa_unit(T, b, h, qb, fr, fq); continue; }
            r -= B_CXA;
            if (r < B_CXB) { const int qb = r & 15, kvh = r >> 4; ctxb_unit(T, sink, b, kvh, qb, fr, fq); continue; }
            r -= B_CXB;
            { const int lo = MLAT + b * CTXL; conv_unit(HG, YC, wl, dwb, lng, lnb, lo + 16 * r, lo, lo + CTXL, lane); }
        }
    }
    __syncthreads();
}

#define RLX_AGENT __ATOMIC_RELAXED, __HIP_MEMORY_SCOPE_AGENT
#define XB_TMO      128
#define XB_XCNT(j)  (256  + 64 * (j))
#define XB_XSUB(j)  (1280 + 64 * (j))
#define XB_XGEN(j)  (2304 + 64 * (j))
#define XB_TOP      3328
#define XB_TOPGEN   3392
#define XCD_BAR_WORDS 3456
#define XB_SPIN_CAP (1u << 18)

__device__ __forceinline__ unsigned xb_ld(unsigned* p)              { return __hip_atomic_load(p, __ATOMIC_RELAXED, __HIP_MEMORY_SCOPE_AGENT); }
__device__ __forceinline__ unsigned xb_add(unsigned* p, unsigned v) { return __hip_atomic_fetch_add(p, v, __ATOMIC_RELAXED, __HIP_MEMORY_SCOPE_AGENT); }
__device__ __forceinline__ unsigned xb_xcc_id() { return (unsigned)__builtin_amdgcn_s_getreg((3 << 11) | 20) & 0xFu; }
#define XB_SPIN(cond, bar) do { unsigned _sp = 0; while (cond) { __builtin_amdgcn_s_sleep(1); \
    if ((++_sp & 255u) == 0u) { if (xb_ld(&(bar)[XB_TMO])) break; if (_sp > XB_SPIN_CAP) { atomicAdd(&(bar)[XB_TMO], 1u); break; } } } } while (0)

struct XcdBarrier {
    unsigned* bar; unsigned x;
    volatile LAS unsigned* st;
};

__device__ __forceinline__ XcdBarrier xcd_barrier_post(unsigned* bar, volatile LAS unsigned* st) {
    XcdBarrier b; b.bar = bar; b.x = xb_xcc_id(); b.st = st;
    if (threadIdx.x == 0) (void)xb_add(&bar[XB_XCNT(b.x)], 1u);
    return b;
}
__device__ __forceinline__ void xcd_barrier_complete(unsigned* bar, unsigned x, unsigned& nloc, unsigned& nx) {
    const unsigned G = gridDim.x * gridDim.y * gridDim.z;
    unsigned sum, cnt, mine, sp = 0u;
    for (;;) {
        sum = 0u; cnt = 0u; mine = 0u;
#pragma unroll
        for (unsigned j = 0; j < 16; ++j) { const unsigned c = xb_ld(&bar[XB_XCNT(j)]); sum += c; cnt += (c > 0u) ? 1u : 0u; mine = (j == x) ? c : mine; }
        if (sum == G) break;
        __builtin_amdgcn_s_sleep(1);
        if ((++sp & 255u) == 0u) { if (xb_ld(&bar[XB_TMO])) break; if (sp > XB_SPIN_CAP) { atomicAdd(&bar[XB_TMO], 1u); break; } }
    }
    nloc = mine > 0u ? mine : 1u; nx = cnt > 0u ? cnt : 1u;
}

__device__ __forceinline__ void xcd_barrier(const XcdBarrier& b) {
    asm volatile("s_waitcnt vmcnt(0)" ::: "memory");
    __syncthreads();
    if (threadIdx.x == 0) {
        unsigned* bar = b.bar;
        __builtin_amdgcn_s_waitcnt(0);
        unsigned nloc = b.st[0], nx = b.st[1];
        if (nloc == 0u) { xcd_barrier_complete(bar, b.x, nloc, nx); b.st[0] = nloc; b.st[1] = nx; }
        const unsigned old = xb_add(&bar[XB_XSUB(b.x)], 1u);
        const unsigned gen = old / nloc;
        if (old + 1u == (gen + 1u) * nloc) {
            __builtin_amdgcn_fence(__ATOMIC_RELEASE, "agent");
            asm volatile("s_waitcnt vmcnt(0)" ::: "memory");
            const unsigned og = xb_add(&bar[XB_TOP], 1u);
            const unsigned tg = og / nx;
            if (og + 1u == (tg + 1u) * nx) xb_add(&bar[XB_TOPGEN], 1u);
            else XB_SPIN(xb_ld(&bar[XB_TOPGEN]) == tg, bar);
            __builtin_amdgcn_fence(__ATOMIC_ACQUIRE, "agent");
            xb_add(&bar[XB_XGEN(b.x)], 1u);
            asm volatile("s_waitcnt vmcnt(0)" ::: "memory");
        } else {
            XB_SPIN(xb_ld(&bar[XB_XGEN(b.x)]) == gen, bar);
            __builtin_amdgcn_fence(__ATOMIC_ACQUIRE, "agent");
            asm volatile("s_waitcnt vmcnt(0)" ::: "memory");
        }
    }
    __syncthreads();
}

#ifdef NO_GEMM
#define GEMM_PHASE(EPI, g, S, E) do { (void)g; (void)S; (void)E; } while (0)
#else
#define GEMM_PHASE(EPI, g, S, E) pg8::gemm_phase<EPI, pg8::StaticOrder, true, true>(ldsp, g, S, E)
#endif
#define CTX_SPLITK(WDN) do { _Pragma("unroll 1") for (int sl = 0; sl < 4; ++sl) { const int kt0 = sl == 0 ? 0 : (sl == 1 ? 12 : (sl == 2 ? 24 : 34)), ntk = sl < 2 ? 12 : 10; \
        pg8::Gemm g2{(const bf16*)R + (size_t)MLAT * DFF + kt0 * 64, (WDN) + kt0 * 64, MCTX, DM, DFF, ntk * 64}; \
        pg8::StaticOrder S2; S2.init(MCTX, DM, G, (bx >= 32 * sl && bx < 32 * sl + 32) ? bx - 32 * sl : (1 << 28)); \
        pg8::EpiF32 E2{(float*)(ws + WS_P) + (size_t)sl * MCTX * DM, DM}; GEMM_PHASE(pg8::EpiF32, g2, S2, E2); } } while (0)

__global__ void __launch_bounds__(NTHR, 2) mk_fwd(Args a_unused) {
    extern __shared__ __attribute__((aligned(16))) unsigned char lds_raw[];
    LAS unsigned char* ldsp = (LAS unsigned char*)lds_raw;
    cg::grid_group grid = cg::this_grid();
#define IN(k) (pa->ph_lo <= (k) && (k) < pa->ph_hi)
#define SEAM(k) do { KArgs pa = kargs(); if (IN(k) && IN((k) + 1)) { XcdBarrier b_; b_.bar = (unsigned*)(pa->ws + WS_BAR); b_.x = xb_xcc_id(); b_.st = (volatile LAS unsigned*)(ldsp + LDS_ST); xcd_barrier(b_); } } while (0)
#define PH_BEGIN(k) { KArgs pa = kargs(); if (IN(k)) { unsigned char* ws = pa->ws; const int G = gridDim.x, bx = blockIdx.x; \
        int tid_l = threadIdx.x; asm volatile("" : "+v"(tid_l)); const int tid = tid_l, lane = tid & 63, wave = __builtin_amdgcn_readfirstlane(tid >> 6); (void)lane; (void)wave; \
        const bf16* W = (const bf16*)(ws + WS_W) + (size_t)l * WL_ELEMS; const float* modl = (const float*)(ws + WS_MOD) + (size_t)l * 9 * NMODC; \
        bf16* X = (bf16*)(ws + WS_XB); bf16* XC = (bf16*)(ws + WS_XC); bf16* H = (bf16*)(ws + WS_H); unsigned char* R = ws + WS_R; bf16* P = (bf16*)(ws + WS_P); \
        const int MP = (l == 1) ? MLAT : MALL; (void)G; (void)bx; (void)W; (void)modl; (void)X; (void)XC; (void)H; (void)R; (void)P; (void)MP;
#define PH_END(k) } } SEAM(k);
#ifndef REPMASK
#define REPMASK 0
#endif
#define REPK(kind) for (int rep_ = 0; rep_ < 1 + ((REPMASK >> (kind)) & 1); ++rep_)

        if (threadIdx.x < 2) ((volatile LAS unsigned*)(ldsp + LDS_ST))[threadIdx.x] = 0u;
    __syncthreads();
    { const int l = 0; PH_BEGIN(0) REPK(0) { prologue(pa, ldsp, tid, lane, wave); __syncthreads(); } } }
      grid.sync();
      { KArgs pa = kargs(); (void)xcd_barrier_post((unsigned*)(pa->ws + WS_BAR), (volatile LAS unsigned*)(ldsp + LDS_ST)); } }
#pragma unroll 1
    for (int l = 0; l < 2; ++l) {
        const int pb = 1 + 11 * l;
        PH_BEGIN(pb + 0) norm_phase(l == 0 ? (const void*)pa->in[0] : (const void*)X, l == 0 ? (const void*)pa->in[2] : (const void*)XC, l == 0, l == 0, pa->in[6] + l * 3 * DM, modl, 0, 1, H, MALL,
                l == 1 ? (const float*)(ws + WS_P) : (const float*)nullptr, (const float*)(ws + WS_MOD) + 8 * NMODC + 8 * DM, 0.5f, XC, lane, wave); PH_END(pb + 0)
        PH_BEGIN(pb + 1) pg8::Gemm g{H, W + WO_GU1, MALL, 2 * DFF, DM}; pg8::StaticOrder S; S.init(MALL, 2 * DFF, G, bx); pg8::EpiSwiGLU E{(bf16*)R, DFF}; REPK(1) GEMM_PHASE(pg8::EpiSwiGLU, g, S, E); PH_END(pb + 1)
        PH_BEGIN(pb + 2) { pg8::Gemm g{(const bf16*)R, W + WO_DN1, MLAT, DM, DFF}; pg8::StaticOrder S; S.init(MLAT, DM, G, bx);
            pg8::EpiResid E{l == 0 ? (const void*)pa->in[0] : (const void*)X, l == 0 ? (const void*)pa->in[2] : (const void*)XC, l == 0 ? 1 : 0, X, XC, modl + 2 * DM, 0.5f}; GEMM_PHASE(pg8::EpiResid, g, S, E); }
            CTX_SPLITK(W + WO_DN1);
        PH_END(pb + 2)
        PH_BEGIN(pb + 3) REPK(3) norm_phase(X, l == 0 ? (const void*)pa->in[2] : (const void*)XC, false, l == 0, pa->in[6] + l * 3 * DM + DM, modl, 3, 4, H, MALL,
                (const float*)(ws + WS_P), modl + 8 * NMODC + 2 * DM, 0.5f, XC, lane, wave); PH_END(pb + 3)
        PH_BEGIN(pb + 4)
            { pg8::Gemm g{H, W + WO_IN, MALL, 1792, DM}; pg8::StaticOrder S; S.init(MALL, 1792, G, bx);
              pg8::EpiIn1 E{(bf16*)(R + R_QB), (bf16*)(R + R_KB), (bf16*)(R + R_QA), (bf16*)(R + R_KA), (bf16*)(R + R_HG), (const float*)(ws + WS_ROPE), SCL2}; GEMM_PHASE(pg8::EpiIn1, g, S, E); }
            { pg8::Gemm g{W + WO_IN + (size_t)1792 * DM, H, 512, MALL, DM}; pg8::StaticOrder S; S.init(512, MALL, G, G - 1 - bx); pg8::EpiBf16 E{(bf16*)(R + R_VT), MALL};   GEMM_PHASE(pg8::EpiBf16, g, S, E); }
        PH_END(pb + 4)
        #ifndef NO_MIX
        PH_BEGIN(pb + 5) mixer_phase<0>(pa, ldsp, l, tid, lane, wave);
        PH_END(pb + 5)
#endif
        PH_BEGIN(pb + 6)
            REPK(6)
#pragma unroll 1
            for (int br = 0; br < 3; ++br) {
                const bf16* Y = (const bf16*)(R + (br == 0 ? R_YA : (br == 1 ? R_YB : R_YC))); const int Kb = br == 2 ? 256 : 384;
                const bf16* Wb = W + (br == 0 ? WO_OA : (br == 1 ? WO_OB : WO_OC));
                { pg8::Gemm g{Y, Wb, MP, DM, Kb}; pg8::StaticOrder S; S.init(MP, DM, G, bx); pg8::EpiBf16 E{P, DM}; GEMM_PHASE(pg8::EpiBf16, g, S, E); }
                { pg8::Gemm g{H, W + WO_IN + (size_t)(2304 + 1024 * br) * DM, MP, DM, DM}; pg8::StaticOrder S; S.init(MP, DM, G, bx);
                  pg8::EpiGate E{P, (bf16*)R, pa->in[12] + l * 3072 + br * 1024, br}; GEMM_PHASE(pg8::EpiGate, g, S, E); }
            }
        PH_END(pb + 6)
        PH_BEGIN(pb + 7) pg8::Gemm g{P, W + WO_WO, MP, DM, DM}; pg8::StaticOrder S; S.init(MP, DM, G, bx); pg8::EpiResid E{X, XC, 0, X, XC, modl + 5 * DM, 1.0f}; GEMM_PHASE(pg8::EpiResid, g, S, E); PH_END(pb + 7)
        PH_BEGIN(pb + 8) norm_phase(X, XC, false, false, pa->in[6] + l * 3 * DM + 2 * DM, modl, 6, 7, H, MP, (const float*)nullptr, (const float*)nullptr, 0.f, XC, lane, wave); PH_END(pb + 8)
        PH_BEGIN(pb + 9) pg8::Gemm g{H, W + WO_GU2, MP, 2 * DFF, DM}; pg8::StaticOrder S; S.init(MP, 2 * DFF, G, bx); pg8::EpiSwiGLU E{(bf16*)R, DFF}; GEMM_PHASE(pg8::EpiSwiGLU, g, S, E); PH_END(pb + 9)
        PH_BEGIN(pb + 10) { pg8::Gemm g{(const bf16*)R, W + WO_DN2, MLAT, DM, DFF}; pg8::StaticOrder S; S.init(MLAT, DM, G, bx); pg8::EpiResid E{X, XC, 0, X, XC, modl + 8 * DM, 0.5f}; GEMM_PHASE(pg8::EpiResid, g, S, E); }
            if (l == 0) CTX_SPLITK(W + WO_DN2);
        PH_END(pb + 10)
    }
#ifdef PROBE_SYNCS
    for (int i_ = 0; i_ < 24; ++i_) grid.sync();
#endif
    { const int l = 0; PH_BEGIN(23) final_norm(X, pa->out, pa->in[23], lane, wave); } } }
#undef IN
#undef SEAM
}

#ifndef MK_MULTI
#define MK_MULTI 0
#endif
extern "C" void kernel_launch(void* const* d_in, const int* in_sizes, int n_in, void* d_out, int out_size, void* d_ws, size_t ws_size, hipStream_t stream) {
    static int grid = 0;
    if (grid == 0) {
        if (n_in != 24 || out_size != MLAT * DM || ws_size < WS_END) { fprintf(stderr, "kernel_launch: unexpected shapes (n_in %d out %d ws %zu)\n", n_in, out_size, ws_size); grid = -1; return; }
        int dev = 0, cus = 0, per_cu = 0;
        if (hipGetDevice(&dev) != hipSuccess || hipDeviceGetAttribute(&cus, hipDeviceAttributeMultiprocessorCount, dev) != hipSuccess) { grid = -1; return; }
        if (hipFuncSetAttribute((const void*)mk_fwd, hipFuncAttributeMaxDynamicSharedMemorySize, LDS_BYTES) != hipSuccess) { fprintf(stderr, "kernel_launch: hipFuncSetAttribute failed\n"); grid = -1; return; }
        if (hipOccupancyMaxActiveBlocksPerMultiprocessor(&per_cu, (const void*)mk_fwd, NTHR, LDS_BYTES) != hipSuccess || per_cu < 1) { fprintf(stderr, "kernel_launch: occupancy query says %d\n", per_cu); per_cu = 1; }
        (void)hipGetLastError();
        grid = cus * per_cu;
    }
    if (grid < 0) return;
    Args a{};
    for (int i = 0; i < 24; ++i) a.in[i] = (const float*)d_in[i];
    a.out = (float*)d_out; a.ws = (unsigned char*)d_ws;
#if MK_MULTI
    for (int p = 0; p < 24; ++p) { a.ph_lo = p; a.ph_hi = p + 1; hipLaunchKernelGGL(mk_fwd, dim3(grid), dim3(NTHR), LDS_BYTES, stream, a); }
#else
    a.ph_lo = 0; a.ph_hi = 24;
    void* args[] = {&a};
    hipError_t e = hipLaunchCooperativeKernel((const void*)mk_fwd, dim3(grid), dim3(NTHR), args, LDS_BYTES, stream);
    if (e != hipSuccess) fprintf(stderr, "cooperative launch failed: %s (grid %d)\n", hipGetErrorString(e), grid);
#endif
}
```

```cpp
#include <hip/hip_runtime.h>
#include <hip/hip_cooperative_groups.h>
#include <cstdio>
#include <cstdint>
namespace cg = cooperative_groups;
namespace pg8 {
#define PG8_LAS __attribute__((address_space(3)))
typedef unsigned short bf16_t;
typedef short bf16x8 __attribute__((ext_vector_type(8)));
typedef float f32x4 __attribute__((ext_vector_type(4)));
typedef unsigned u32x4 __attribute__((ext_vector_type(4)));
constexpr int BM = 256, BK = 64, HALF = 128, HTB = HALF * BK * 2  , STAGE_BYTES = 8 * HTB, NXCD = 8, WGM = 8;

__host__ __device__ __forceinline__ int lds_byte(int r, int c) { const int st = (r >> 4) * 2 + (c >> 5), rr = r & 15, cc = c & 31, ob = rr * 64 + cc * 2; return st * 1024 + (ob ^ (((ob >> 9) & 1) << 5)); }
__host__ __device__ __forceinline__ void stage_rc(int b, int& R, int& C) { const int st = b / 1024, sb = b % 1024, swz = sb ^ (((sb >> 9) & 1) << 5); R = (st >> 1) * 16 + swz / 64; C = (st & 1) * 32 + (swz % 64) / 2; }
__host__ __device__ __forceinline__ int perm32(int rho) { const int n = rho >> 4, i = rho & 15; return 8 * (i >> 2) + 4 * n + (i & 3); }

struct Unit { int pm, pn; };
struct Gemm { const bf16_t* A; const bf16_t* Bt; int M, N, K; int Kx; };

struct StaticOrder {
    int nM, nN, nwg, G, c;
    __host__ __device__ void init(int M, int N, int G_, int c_) { nM = M / BM; nN = N / BM; nwg = nM * nN; G = G_; c = c_; }
    __host__ __device__ bool next(int i, Unit& u) const {
        const long L = (long)i * G + c; if (L >= nwg) return false;
        int wgid = (int)L; { const int q = nwg / NXCD, r = nwg % NXCD, xcd = wgid % NXCD, off = wgid / NXCD; wgid = (xcd < r ? xcd * (q + 1) : r * (q + 1) + (xcd - r) * q) + off; }
        const int nig = WGM * nN, gid = wgid / nig, fm = gid * WGM, gsz = (nM - fm) < WGM ? (nM - fm) : WGM;
        u.pm = fm + ((wgid % nig) % gsz); u.pn = (wgid % nig) / gsz; return true;
    }
    __device__ __forceinline__ void a_ready(const Unit&) const {}
    __device__ __forceinline__ void done(const Unit&) const {}
};

__device__ __forceinline__ unsigned cvt_pk_bf16(float lo, float hi) { unsigned r; asm volatile("v_cvt_pk_bf16_f32 %0, %1, %2" : "=v"(r) : "v"(lo), "v"(hi)); return r; }
__device__ __forceinline__ float sigm(float x) { return __builtin_amdgcn_rcpf(1.f + __expf(-x)); }
__device__ __forceinline__ u32x4 pack8(const f32x4& v0, const f32x4& v1) { u32x4 w; w.x = cvt_pk_bf16(v0[0], v0[1]); w.y = cvt_pk_bf16(v0[2], v0[3]); w.z = cvt_pk_bf16(v1[0], v1[1]); w.w = cvt_pk_bf16(v1[2], v1[3]); return w; }
__device__ __forceinline__ f32x4 bflo(unsigned a, unsigned b) { f32x4 r; r[0] = __builtin_bit_cast(float, a << 16); r[1] = __builtin_bit_cast(float, a & 0xffff0000u); r[2] = __builtin_bit_cast(float, b << 16); r[3] = __builtin_bit_cast(float, b & 0xffff0000u); return r; }

struct EpiSwiGLU {
    static constexpr bool PERM = true, AFTER_DRAIN = false;
    bf16_t* O; int ldc;
    __device__ __forceinline__ void operator()(const f32x4 (&acc)[2][2][4][2], const Unit& u, int wr, int wc, int fr, int fq) const {
        const int row0 = u.pm * BM + wr * 64 + fr, col0 = u.pn * HALF + wc * 32 + 8 * fq;
#pragma unroll
        for (int ai = 0; ai < 2; ++ai)
#pragma unroll
            for (int m = 0; m < 4; ++m) {
                f32x4 v[2];
#pragma unroll
                for (int n = 0; n < 2; ++n)
#pragma unroll
                    for (int j = 0; j < 4; ++j) { const float a = acc[ai][0][m][n][j], b = acc[ai][1][m][n][j]; v[n][j] = a * sigm(a) * b; }
                *(u32x4*)(O + (size_t)(row0 + ai * HALF + m * 16) * ldc + col0) = pack8(v[0], v[1]);
            }
    }
};

struct EpiResid {
    static constexpr bool PERM = true, AFTER_DRAIN = false;
    const void* srcL; const void* srcC; int src_f32; bf16_t* dstL; bf16_t* dstC; const float* gate; float coef;
    __device__ __forceinline__ void operator()(const f32x4 (&acc)[2][2][4][2], const Unit& u, int wr, int wc, int fr, int fq) const {
        const bool lat = u.pm < 128;
        const size_t tile0 = (size_t)(lat ? u.pm : u.pm - 128) * BM * 1024;
        const void* srcv = lat ? srcL : srcC;
        bf16_t* dst = (lat ? dstL : dstC) + tile0;
        const float* g = gate + (lat ? (u.pm >> 4) : 8) * 9216;
        const int rl = wr * 64 + fr, col0 = u.pn * BM + wc * 32 + 8 * fq;
        f32x4 gv[2][2];
#pragma unroll
        for (int bj = 0; bj < 2; ++bj)
#pragma unroll
            for (int n = 0; n < 2; ++n) gv[bj][n] = *(const f32x4*)(g + col0 + bj * HALF + 4 * n) * coef;
#pragma unroll
        for (int ai = 0; ai < 2; ++ai)
#pragma unroll
            for (int m = 0; m < 4; ++m)
#pragma unroll
                for (int bj = 0; bj < 2; ++bj) {
                    const size_t off = (size_t)(rl + ai * HALF + m * 16) * 1024 + col0 + bj * HALF;
                    f32x4 x0, x1;
                    if (src_f32) { const float* sp = (const float*)srcv + tile0 + off; x0 = __builtin_nontemporal_load((const f32x4*)sp); x1 = __builtin_nontemporal_load((const f32x4*)(sp + 4)); }
                    else { const u32x4 w = *(const u32x4*)((const bf16_t*)srcv + tile0 + off); x0 = bflo(w.x, w.y); x1 = bflo(w.z, w.w); }
                    *(u32x4*)(dst + off) = pack8(x0 + gv[bj][0] * acc[ai][bj][m][0], x1 + gv[bj][1] * acc[ai][bj][m][1]);
                }
    }
};

struct EpiIn1 {
    static constexpr bool PERM = true, AFTER_DRAIN = false;
    bf16_t *QB, *KB, *QA, *KA, *HG; const float* rope; float qs;
    __device__ __forceinline__ void operator()(const f32x4 (&acc)[2][2][4][2], const Unit& u, int wr, int wc, int fr, int fq) const {
        const int row0 = u.pm * BM + wr * 64 + fr; const bool lat = u.pm < 128; const int pn = u.pn;
        if (pn < 2) {
            const int g8 = 4 * pn + wc; bf16_t* dst = g8 < 6 ? QB + g8 * 64 : KB + (g8 - 6) * 64; const int ld = g8 < 6 ? 384 : 128; const float sc = g8 < 6 ? qs : 1.f;
#pragma unroll
            for (int ai = 0; ai < 2; ++ai)
#pragma unroll
                for (int m = 0; m < 4; ++m) {
                    const int row = row0 + ai * HALF + m * 16;
                    f32x4 y1[2], y2[2];
                    if (lat) {
                        const int t = row & 4095, pos = fq < 2 ? (t >> 6) : (t & 63); const float* rp = rope + pos * 16 + 8 * (fq & 1);
#pragma unroll
                        for (int n = 0; n < 2; ++n) { const f32x4 c = *(const f32x4*)(rp + 4 * n), s = *(const f32x4*)(rp + 1024 + 4 * n);
                            const f32x4 x1 = acc[ai][0][m][n], x2 = acc[ai][1][m][n]; y1[n] = x1 * c - x2 * s; y2[n] = x1 * s + x2 * c; }
                    } else { y1[0] = acc[ai][0][m][0]; y1[1] = acc[ai][0][m][1]; y2[0] = acc[ai][1][m][0]; y2[1] = acc[ai][1][m][1]; }
                    bf16_t* rowp = dst + (size_t)row * ld + 8 * fq;
                    *(u32x4*)(rowp) = pack8(y1[0] * sc, y1[1] * sc); *(u32x4*)(rowp + 32) = pack8(y2[0] * sc, y2[1] * sc);
                }
        } else if (pn < 5) {
#pragma unroll
            for (int bj = 0; bj < 2; ++bj) {
                const int c = (pn - 2) * BM + bj * HALF + wc * 32 + 8 * fq; bf16_t* dst = c < 384 ? QA + c : KA + (c - 384); const float sc = c < 384 ? qs : 1.f;
#pragma unroll
                for (int ai = 0; ai < 2; ++ai)
#pragma unroll
                    for (int m = 0; m < 4; ++m) *(u32x4*)(dst + (size_t)(row0 + ai * HALF + m * 16) * 384) = pack8(acc[ai][bj][m][0] * sc, acc[ai][bj][m][1] * sc);
            }
        } else {
            const int col = (pn - 5) * HALF + wc * 32 + 8 * fq;
#pragma unroll
            for (int ai = 0; ai < 2; ++ai)
#pragma unroll
                for (int m = 0; m < 4; ++m) {
                    f32x4 v[2];
#pragma unroll
                    for (int n = 0; n < 2; ++n)
#pragma unroll
                        for (int j = 0; j < 4; ++j) v[n][j] = acc[ai][0][m][n][j] * sigm(acc[ai][1][m][n][j]);
                    *(u32x4*)(HG + (size_t)(row0 + ai * HALF + m * 16) * 256 + col) = pack8(v[0], v[1]);
                }
        }
    }
};

struct EpiBf16 {
    static constexpr bool PERM = true, AFTER_DRAIN = false;
    bf16_t* O; int ldc;
    __device__ __forceinline__ void operator()(const f32x4 (&acc)[2][2][4][2], const Unit& u, int wr, int wc, int fr, int fq) const {
        const int row0 = u.pm * BM + wr * 64 + fr, col0 = u.pn * BM + wc * 32 + 8 * fq;
#pragma unroll
        for (int ai = 0; ai < 2; ++ai)
#pragma unroll
            for (int m = 0; m < 4; ++m)
#pragma unroll
                for (int bj = 0; bj < 2; ++bj) *(u32x4*)(O + (size_t)(row0 + ai * HALF + m * 16) * ldc + col0 + bj * HALF) = pack8(acc[ai][bj][m][0], acc[ai][bj][m][1]);
    }
};

struct EpiF32 {
    static constexpr bool PERM = true, AFTER_DRAIN = false;
    float* O; int ldc;
    __device__ __forceinline__ void operator()(const f32x4 (&acc)[2][2][4][2], const Unit& u, int wr, int wc, int fr, int fq) const {
        const int row0 = u.pm * BM + wr * 64 + fr, col0 = u.pn * BM + wc * 32 + 8 * fq;
#pragma unroll
        for (int ai = 0; ai < 2; ++ai)
#pragma unroll
            for (int m = 0; m < 4; ++m)
#pragma unroll
                for (int bj = 0; bj < 2; ++bj) { float* o = O + (size_t)(row0 + ai * HALF + m * 16) * ldc + col0 + bj * HALF; *(f32x4*)o = acc[ai][bj][m][0]; *(f32x4*)(o + 4) = acc[ai][bj][m][1]; }
    }
};

struct EpiGate {
    static constexpr bool PERM = true, AFTER_DRAIN = false;
    bf16_t* P; bf16_t* T; const float* bg; int br;
    __device__ __forceinline__ void operator()(const f32x4 (&acc)[2][2][4][2], const Unit& u, int wr, int wc, int fr, int fq) const {
        const int row0 = u.pm * BM + wr * 64 + fr, col0 = u.pn * BM + wc * 32 + 8 * fq;
        f32x4 bv[2][2];
#pragma unroll
        for (int bj = 0; bj < 2; ++bj)
#pragma unroll
            for (int n = 0; n < 2; ++n) bv[bj][n] = *(const f32x4*)(bg + col0 + bj * HALF + 4 * n);
#pragma unroll
        for (int ai = 0; ai < 2; ++ai)
#pragma unroll
            for (int m = 0; m < 4; ++m)
#pragma unroll
                for (int bj = 0; bj < 2; ++bj) {
                    const size_t off = (size_t)(row0 + ai * HALF + m * 16) * 1024 + col0 + bj * HALF;
                    const u32x4 pw = *(const u32x4*)(P + off);
                    const f32x4 p0 = bflo(pw.x, pw.y), p1 = bflo(pw.z, pw.w);
                    f32x4 t0, t1;
#pragma unroll
                    for (int j = 0; j < 4; ++j) { t0[j] = sigm(acc[ai][bj][m][0][j] + bv[bj][0][j]) * p0[j]; t1[j] = sigm(acc[ai][bj][m][1][j] + bv[bj][1][j]) * p1[j]; }
                    if (br != 0) { const u32x4 tw = *(const u32x4*)(T + off); t0 = t0 + bflo(tw.x, tw.y); t1 = t1 + bflo(tw.z, tw.w); }
                    *(u32x4*)((br == 2 ? P : T) + off) = pack8(t0, t1);
                }
    }
};

template <class Epi, class Sched, bool ALIGN_EPI = false, bool SP2 = false>
__device__ __forceinline__ void gemm_phase(PG8_LAS unsigned char* lds, const Gemm g, const Sched& S, const Epi& E) {
    int tid_l = threadIdx.x; asm volatile("" : "+v"(tid_l));
    const int tid = tid_l, wid = __builtin_amdgcn_readfirstlane(tid >> 6), lane = tid & 63, wr = wid >> 2, wc = wid & 3, fr = lane & 15, fq = lane >> 4;
    const int K = g.K, nt = (g.Kx ? g.Kx : K) / BK;
    unsigned voffA[2], voffB[2];
#pragma unroll
    for (int i = 0; i < 2; ++i) { int R, C; stage_rc(tid * 16 + i * 8192, R, C); const int Rb = Epi::PERM ? ((R & ~31) + perm32(R & 31)) : R;
        voffA[i] = (unsigned)(R * K + C) * 2u; voffB[i] = (unsigned)(Rb * K + C) * 2u; }
    const size_t kstep = (size_t)(BK * 2);
    const size_t hstep = (size_t)HALF * K * 2;
    const size_t tstep = 2 * hstep;
    const unsigned ldsw = (unsigned)wid * 1024u;
    const int aoff = lds_byte(wr * 64 + fr, fq * 8), boff = lds_byte(wc * 32 + fr, fq * 8);
#define PG8_SA(b, h) (((b) * 2 + (h)) * HTB)
#define PG8_SB(b, h) ((4 + (b) * 2 + (h)) * HTB)
#define PG8_STAGE(bufoff, gbase, voff) do { _Pragma("unroll") for (int _i = 0; _i < 2; ++_i) \
        __builtin_amdgcn_global_load_lds((const unsigned*)((const char*)(gbase) + (voff)[_i]), (PG8_LAS unsigned*)(lds + (bufoff) + ldsw + _i * 8192), 16, 0, 0); } while (0)
#define PG8_LDA(dst, b, h) do { _Pragma("unroll") for (int m = 0; m < 4; ++m) _Pragma("unroll") for (int k = 0; k < 2; ++k) dst[m][k] = *(const PG8_LAS bf16x8*)(lds + PG8_SA(b, h) + aoff + m * 2048 + k * 1024); } while (0)
#define PG8_LDB(dst, b, h) do { _Pragma("unroll") for (int n = 0; n < 2; ++n) _Pragma("unroll") for (int k = 0; k < 2; ++k) dst[n][k] = *(const PG8_LAS bf16x8*)(lds + PG8_SB(b, h) + boff + n * 2048 + k * 1024); } while (0)
#define PG8_MMA(ai, bj, At, Bt) do { __builtin_amdgcn_s_setprio(1); _Pragma("unroll") for (int m = 0; m < 4; ++m) _Pragma("unroll") for (int n = 0; n < 2; ++n) _Pragma("unroll") for (int k = 0; k < 2; ++k) \
        acc[ai][bj][m][n] = __builtin_amdgcn_mfma_f32_16x16x32_bf16(Bt[n][k], At[m][k], acc[ai][bj][m][n], 0, 0, 0); __builtin_amdgcn_s_setprio(0); } while (0)
#define PG8_WAIT_V(n) asm volatile("s_waitcnt vmcnt(" #n ")" ::: "memory")
#define PG8_WAIT_L(n) asm volatile("s_waitcnt lgkmcnt(" #n ")" ::: "memory")
#define PG8_BAR __builtin_amdgcn_s_barrier()
#define PG8_SCHED __builtin_amdgcn_sched_barrier(0)
    Unit cur, nxt; int ui = 0;
    if (!S.next(0, cur)) return;
    f32x4 acc[2][2][4][2];
#pragma unroll
    for (int a = 0; a < 2; ++a)
#pragma unroll
        for (int b = 0; b < 2; ++b)
#pragma unroll
            for (int m = 0; m < 4; ++m)
#pragma unroll
                for (int n = 0; n < 2; ++n) acc[a][b][m][n] = (f32x4){0.f, 0.f, 0.f, 0.f};
    bf16x8 At[4][2], B0[2][2], B1[2][2];
    const char* cA = (const char*)g.A + (size_t)cur.pm * tstep; const char* cB = (const char*)g.Bt + (size_t)cur.pn * tstep;
    S.a_ready(cur);
    if constexpr (SP2) {
        PG8_STAGE(PG8_SB(0, 0), cB, voffB); PG8_STAGE(PG8_SB(0, 1), cB + hstep, voffB); PG8_STAGE(PG8_SA(0, 0), cA, voffA); PG8_STAGE(PG8_SA(0, 1), cA + hstep, voffA);
        if (wr == 1) PG8_BAR;
        PG8_WAIT_V(2); PG8_BAR;
        PG8_STAGE(PG8_SB(1, 0), cB + kstep, voffB); PG8_STAGE(PG8_SA(1, 0), cA + kstep, voffA); PG8_STAGE(PG8_SB(1, 1), cB + hstep + kstep, voffB);
        PG8_WAIT_V(6); PG8_BAR;
    } else {
        PG8_STAGE(PG8_SB(0, 0), cB, voffB); PG8_STAGE(PG8_SA(0, 0), cA, voffA); PG8_STAGE(PG8_SB(0, 1), cB + hstep, voffB); PG8_STAGE(PG8_SA(0, 1), cA + hstep, voffA);
        if (wr == 1) PG8_BAR;
        PG8_WAIT_V(4); PG8_BAR;
        PG8_STAGE(PG8_SB(1, 0), cB + kstep, voffB); PG8_STAGE(PG8_SA(1, 0), cA + kstep, voffA); PG8_STAGE(PG8_SB(1, 1), cB + hstep + kstep, voffB);
        PG8_WAIT_V(6); PG8_BAR;
    }
    for (;;) {
        const bool has_next = S.next(ui + 1, nxt);
        const char* nA = has_next ? (const char*)g.A + (size_t)nxt.pm * tstep : cA; const char* nB = has_next ? (const char*)g.Bt + (size_t)nxt.pn * tstep : cB;
        for (int t = 0; t < nt; t += 2) {
            const bool last = (t == nt - 2);
            const char* a1 = cA + (size_t)(t + 1) * kstep;
            const char* a2 = last ? nA : cA + (size_t)(t + 2) * kstep; const char* b2 = last ? nB : cB + (size_t)(t + 2) * kstep;
            const char* a3 = a2 + kstep; const char* b3 = b2 + kstep;
            if (last && has_next) S.a_ready(nxt);
            if constexpr (SP2) {
            PG8_LDB(B0, 0, 0); PG8_LDB(B1, 0, 1); PG8_SCHED; PG8_LDA(At, 0, 0); PG8_STAGE(PG8_SA(1, 1), a1 + hstep, voffA);
            PG8_WAIT_V(8); PG8_WAIT_L(0); PG8_BAR; PG8_MMA(0, 0, At, B0); PG8_MMA(0, 1, At, B1); PG8_BAR; PG8_SCHED;
            PG8_LDA(At, 0, 1); PG8_STAGE(PG8_SB(0, 0), b2, voffB); PG8_STAGE(PG8_SB(0, 1), b2 + hstep, voffB); PG8_STAGE(PG8_SA(0, 0), a2, voffA);
            PG8_WAIT_V(8); PG8_WAIT_L(0); PG8_BAR; PG8_MMA(1, 0, At, B0); PG8_MMA(1, 1, At, B1); PG8_BAR; PG8_SCHED;
            PG8_LDB(B0, 1, 0); PG8_LDB(B1, 1, 1); PG8_SCHED; PG8_LDA(At, 1, 0); PG8_STAGE(PG8_SA(0, 1), a2 + hstep, voffA);
            PG8_WAIT_V(8); PG8_WAIT_L(0); PG8_BAR; PG8_MMA(0, 0, At, B0); PG8_MMA(0, 1, At, B1); PG8_BAR; PG8_SCHED;
            PG8_LDA(At, 1, 1); PG8_STAGE(PG8_SB(1, 0), b3, voffB); PG8_STAGE(PG8_SB(1, 1), b3 + hstep, voffB); PG8_STAGE(PG8_SA(1, 0), a3, voffA);
            PG8_WAIT_V(8); PG8_WAIT_L(0); PG8_BAR; PG8_MMA(1, 0, At, B0); PG8_MMA(1, 1, At, B1); PG8_BAR; PG8_SCHED;
            } else {
            PG8_LDB(B0, 0, 0); PG8_SCHED; PG8_LDA(At, 0, 0); PG8_STAGE(PG8_SA(1, 1), a1 + hstep, voffA);
            PG8_WAIT_L(8); PG8_BAR; PG8_WAIT_L(0); PG8_MMA(0, 0, At, B0); PG8_BAR; PG8_SCHED;
            PG8_LDB(B1, 0, 1); PG8_STAGE(PG8_SB(0, 0), b2, voffB);
            PG8_BAR; PG8_WAIT_L(0); PG8_MMA(0, 1, At, B1); PG8_BAR;
            PG8_LDA(At, 0, 1); PG8_STAGE(PG8_SA(0, 0), a2, voffA);
            PG8_BAR; PG8_WAIT_L(0); PG8_MMA(1, 0, At, B0); PG8_BAR; PG8_SCHED;
            PG8_STAGE(PG8_SB(0, 1), b2 + hstep, voffB);
            PG8_WAIT_V(6); PG8_BAR; PG8_MMA(1, 1, At, B1); PG8_BAR;
            PG8_LDB(B0, 1, 0); PG8_SCHED; PG8_LDA(At, 1, 0); PG8_STAGE(PG8_SA(0, 1), a2 + hstep, voffA);
            PG8_WAIT_L(8); PG8_BAR; PG8_WAIT_L(0); PG8_MMA(0, 0, At, B0); PG8_BAR; PG8_SCHED;
            PG8_LDB(B1, 1, 1); PG8_STAGE(PG8_SB(1, 0), b3, voffB);
            PG8_BAR; PG8_WAIT_L(0); PG8_MMA(0, 1, At, B1); PG8_BAR;
            PG8_LDA(At, 1, 1); PG8_STAGE(PG8_SA(1, 0), a3, voffA);
            PG8_BAR; PG8_WAIT_L(0); PG8_MMA(1, 0, At, B0); PG8_BAR; PG8_SCHED;
            PG8_STAGE(PG8_SB(1, 1), b3 + hstep, voffB);
            PG8_WAIT_V(6); PG8_BAR; PG8_MMA(1, 1, At, B1); PG8_BAR;
            }
        }
        if constexpr (ALIGN_EPI) { if (wr == 0) PG8_BAR; }
        if constexpr (!Epi::AFTER_DRAIN) { E(acc, cur, wr, wc, fr, fq); S.done(cur); }
        if (!has_next) break;
#pragma unroll
        for (int a = 0; a < 2; ++a)
#pragma unroll
            for (int b = 0; b < 2; ++b)
#pragma unroll
                for (int m = 0; m < 4; ++m)
#pragma unroll
                    for (int n = 0; n < 2; ++n) acc[a][b][m][n] = (f32x4){0.f, 0.f, 0.f, 0.f};
        cur = nxt; cA = nA; cB = nB; ++ui;
        if constexpr (ALIGN_EPI) { if (wr == 1) PG8_BAR; }
    }
    PG8_WAIT_V(0);
    if constexpr (!ALIGN_EPI) { if (wr == 0) PG8_BAR; }
    PG8_BAR;
    if constexpr (Epi::AFTER_DRAIN) { E.fused(acc, cur, wr, wc, fr, fq, lds, wid, lane); S.done(cur); }
#undef PG8_SA
#undef PG8_SB
#undef PG8_STAGE
#undef PG8_LDA
#undef PG8_LDB
#undef PG8_MMA
#undef PG8_WAIT_V
#undef PG8_WAIT_L
#undef PG8_BAR
#undef PG8_SCHED
}
}

#define LAS __attribute__((address_space(3)))
typedef unsigned short bf16;
typedef float f32x4 __attribute__((ext_vector_type(4)));
typedef short bf16x8 __attribute__((ext_vector_type(8)));
typedef unsigned u32x4 __attribute__((ext_vector_type(4)));
typedef unsigned u32x2 __attribute__((ext_vector_type(2)));

constexpr int DM = 1024, NB = 8, SEQ = 4096, MLAT = NB * SEQ, CTXL = 256, MCTX = NB * CTXL, MALL = MLAT + MCTX, DFF = 2816;
constexpr int NMODC = 9 * DM, IN_DIM = 5376;
constexpr float LOG2E = 1.4426950408889634f, SCL2 = 0.125f * LOG2E, NEGB = -1e30f, RMS_EPS = 1e-6f;
constexpr int NWAVES = 8, NTHR = 512;
constexpr int LDS_BYTES = 147456, LDS_ST = 147456 - 64;

constexpr size_t MiB = 1u << 20;
constexpr size_t WS_MOD = 0, WS_ROPE = 1 * MiB, WS_CTR = 1 * MiB + 65536, WS_BAR = 1 * MiB + 131072, WS_XC = 2 * MiB, WS_H = 10 * MiB, WS_R = 78 * MiB, WS_P = 282 * MiB, WS_W = 350 * MiB, WS_XB = 445 * MiB, WS_END = 509 * MiB;
constexpr size_t R_QB = 0, R_KB = R_QB + (size_t)MALL * 384 * 2, R_QA = R_KB + (size_t)MALL * 128 * 2, R_KA = R_QA + (size_t)MALL * 384 * 2, R_HG = R_KA + (size_t)MALL * 384 * 2,
                 R_VT = R_HG + (size_t)MALL * 256 * 2, R_YA = R_VT + (size_t)MALL * 512 * 2, R_YB = R_YA + (size_t)MALL * 384 * 2, R_YC = R_YB + (size_t)MALL * 384 * 2, R_END = R_YC + (size_t)MALL * 256 * 2;
static_assert(R_YA == (size_t)MALL * 1024 * 4 && R_END <= 204 * MiB && (size_t)MALL * DFF * 2 <= 204 * MiB, "region map");
constexpr size_t WO_GU1 = 0, WO_DN1 = 5767168, WO_GU2 = 8650752, WO_DN2 = 14417920, WO_IN = 17301504, WO_OA = 22806528, WO_OB = 23199744, WO_OC = 23592960, WO_WO = 23855104, WL_ELEMS = 24903680;
static_assert(WS_W + 2 * WL_ELEMS * 2 <= WS_XB && WS_XB + (size_t)MLAT * DM * 2 <= WS_END, "weights / residual map");

struct Args { const float* in[24]; float* out; unsigned char* ws; int ph_lo, ph_hi; };
typedef const __attribute__((address_space(4))) Args* KArgs;
__device__ __forceinline__ KArgs kargs() { KArgs p = (KArgs)__builtin_amdgcn_kernarg_segment_ptr(); asm volatile("" : "+s"(p)); return p; }

__device__ __forceinline__ float wave_sum(float v) {
#pragma unroll
    for (int o = 1; o < 64; o <<= 1) v += __shfl_xor(v, o);
    return v;
}
__device__ __forceinline__ unsigned pk2(float lo, float hi) { return pg8::cvt_pk_bf16(lo, hi); }
__device__ __forceinline__ float silu_f(float x) { return x * __builtin_amdgcn_rcpf(1.f + __expf(-x)); }
__device__ __forceinline__ float ex2(float x) { return __builtin_amdgcn_exp2f(x); }

__device__ __forceinline__ int gu_row(int n0) { const int h = n0 >= DFF, r = n0 - h * DFF; return 256 * (r >> 7) + 128 * h + (r & 127); }
__device__ __forceinline__ int in_row(int n0) {
    if (n0 < 768) return 512 + n0;
    if (n0 < 1152) return 1792 + (n0 - 768);
    if (n0 < 1664) { const int s = n0 - 1152, g8 = s >> 6, hf = (s >> 5) & 1; return 256 * (g8 >> 2) + 128 * hf + 32 * (g8 & 3); }
    if (n0 < 1792) return 1792 + 384 + (n0 - 1664);
    if (n0 < 2304) { const int s = n0 - 1792, hf = s >> 8, r = s & 255; return 1280 + 256 * (r >> 7) + 128 * hf + (r & 127); }
    return n0;
}
__device__ __forceinline__ void transpose_item(const float* W, int K, int N, bf16* WT, int k0, int n0, int drow0, LAS float* scr, int lane) {
#pragma unroll 8
    for (int i = 0; i < 32; ++i) { const int kk = 2 * i + (lane >> 5); scr[kk * 33 + (lane & 31)] = __builtin_nontemporal_load(W + (size_t)(k0 + kk) * N + n0 + (lane & 31)); }
    asm volatile("s_waitcnt lgkmcnt(0)" ::: "memory");
    const int c = lane & 7;
#pragma unroll
    for (int j = 0; j < 4; ++j) { const int n = (lane >> 3) + 8 * j; const LAS float* s = scr + (8 * c) * 33 + n;
        u32x4 o; o.x = pk2(s[0 * 33], s[1 * 33]); o.y = pk2(s[2 * 33], s[3 * 33]); o.z = pk2(s[4 * 33], s[5 * 33]); o.w = pk2(s[6 * 33], s[7 * 33]);
        *(u32x4*)(WT + (size_t)(drow0 + n) * K + k0 + 8 * c) = o; }
    asm volatile("s_waitcnt lgkmcnt(0)" ::: "memory");
}

__device__ __forceinline__ void prologue(KArgs pa, LAS unsigned char* lds, int tid, int lane, int wave) {
    const int G = gridDim.x, bx = blockIdx.x;
    float* modv = (float*)(pa->ws + WS_MOD);
    if (bx == 0) { float* rt = (float*)(pa->ws + WS_ROPE);
        if (tid < 36) __hip_atomic_store((unsigned*)(pa->ws + WS_CTR) + 64 * tid, 0u, __ATOMIC_RELAXED, __HIP_MEMORY_SCOPE_AGENT);
        for (int i = tid; i < 3456  ; i += NTHR) __hip_atomic_store((unsigned*)(pa->ws + WS_BAR) + i, 0u, __ATOMIC_RELAXED, __HIP_MEMORY_SCOPE_AGENT);
        for (int i = tid; i < 1024; i += NTHR) { const int pos = i >> 4, f = i & 15; const float inv = exp2f(-(float)f * (13.287712379549449f / 16.f)); const float ang = (float)pos * inv;
            rt[i] = cosf(ang); rt[1024 + i] = sinf(ang); } }
    if (bx < 288) {
        LAS float* sc = (LAS float*)lds; LAS float* part = (LAS float*)(lds + 36864);
        for (int i = tid; i < 9 * DM; i += NTHR) { const int row = i >> 10, k = i & 1023; const float v = row < 8 ? pa->in[1][row * DM + k] : pa->in[3][k]; sc[i] = silu_f(v); }
        __syncthreads();
        for (int unit = bx; unit < 288; unit += G) {
            const int l = unit / 144, cg64 = unit % 144, col = cg64 * 64 + lane;
            const float* w = pa->in[4] + (size_t)l * DM * NMODC + col;
            float acc[9];
#pragma unroll
            for (int r = 0; r < 9; ++r) acc[r] = 0.f;
            for (int k = wave * 128; k < wave * 128 + 128; k += 4) {
                const float w0 = __builtin_nontemporal_load(w + (size_t)k * NMODC), w1 = __builtin_nontemporal_load(w + (size_t)(k + 1) * NMODC), w2 = __builtin_nontemporal_load(w + (size_t)(k + 2) * NMODC), w3 = __builtin_nontemporal_load(w + (size_t)(k + 3) * NMODC);
#pragma unroll
                for (int r = 0; r < 9; ++r) { const f32x4 s = *(const LAS f32x4*)(sc + r * DM + k); acc[r] += s[0] * w0 + s[1] * w1 + s[2] * w2 + s[3] * w3; }
            }
#pragma unroll
            for (int r = 0; r < 9; ++r) part[(wave * 9 + r) * 64 + lane] = acc[r];
            __syncthreads();
            for (int i = tid; i < 576; i += NTHR) { const int r = i >> 6, cl = i & 63; float s = 0.f;
#pragma unroll
                for (int w8 = 0; w8 < 8; ++w8) s += part[(w8 * 9 + r) * 64 + cl];
                modv[((size_t)l * 9 + r) * NMODC + cg64 * 64 + cl] = s + pa->in[5][l * NMODC + cg64 * 64 + cl]; }
            __syncthreads();
        }
    }
    LAS float* scr = (LAS float*)(lds + 65536 + wave * 8704);
    const int gw = bx * NWAVES + wave, NGW = G * NWAVES;
    constexpr int I_GU = 16 * 176, I_DN = 44 * 32, I_IN = 16 * 168, I_OA = 6 * 32, I_OC = 4 * 32, I_WO = 16 * 32, I_L = 2 * I_GU + 2 * I_DN + I_IN + 2 * I_OA + I_OC + I_WO;
    for (int it = gw; it < 2 * I_L; it += NGW) {
        const int l = it / I_L; int r = it - l * I_L;
        bf16* wl = (bf16*)(pa->ws + WS_W) + (size_t)l * WL_ELEMS;
        if (r < 2 * (I_GU + I_DN)) {
            const int f = r / (I_GU + I_DN); r -= f * (I_GU + I_DN);
            if (r < I_GU) { const int kb = r / 176, nb = r % 176; transpose_item(pa->in[7 + 2 * f] + (size_t)l * DM * 2 * DFF, DM, 2 * DFF, wl + (f ? WO_GU2 : WO_GU1), 64 * kb, 32 * nb, gu_row(32 * nb), scr, lane); }
            else { r -= I_GU; const int kb = r / 32, nb = r % 32; transpose_item(pa->in[8 + 2 * f] + (size_t)l * DFF * DM, DFF, DM, wl + (f ? WO_DN2 : WO_DN1), 64 * kb, 32 * nb, 32 * nb, scr, lane); }
            continue;
        }
        r -= 2 * (I_GU + I_DN);
        if (r < I_IN) { const int kb = r / 168, nb = r % 168; transpose_item(pa->in[11] + (size_t)l * DM * IN_DIM, DM, IN_DIM, wl + WO_IN, 64 * kb, 32 * nb, in_row(32 * nb), scr, lane); continue; }
        r -= I_IN;
        if (r < I_OA) { const int kb = r / 32, nb = r % 32; transpose_item(pa->in[19] + (size_t)l * 384 * DM, 384, DM, wl + WO_OA, 64 * kb, 32 * nb, 32 * nb, scr, lane); continue; }
        r -= I_OA;
        if (r < I_OA) { const int kb = r / 32, nb = r % 32; transpose_item(pa->in[20] + (size_t)l * 384 * DM, 384, DM, wl + WO_OB, 64 * kb, 32 * nb, 32 * nb, scr, lane); continue; }
        r -= I_OA;
        if (r < I_OC) { const int kb = r / 32, nb = r % 32; transpose_item(pa->in[21] + (size_t)l * 256 * DM, 256, DM, wl + WO_OC, 64 * kb, 32 * nb, 32 * nb, scr, lane); continue; }
        r -= I_OC;
        { const int kb = r / 32, nb = r % 32; transpose_item(pa->in[22] + (size_t)l * DM * DM, DM, DM, wl + WO_WO, 64 * kb, 32 * nb, 32 * nb, scr, lane); }
    }
}

__device__ __forceinline__ void row_load(f32x4 (&v)[4], const void* base, size_t row, bool f32src, int lane) {
    if (f32src) {
#pragma unroll
        for (int j = 0; j < 4; ++j) v[j] = __builtin_nontemporal_load((const f32x4*)((const float*)base + row * DM) + lane + 64 * j);
    } else {
#pragma unroll
        for (int j = 0; j < 4; ++j) { const u32x2 w = *((const u32x2*)((const bf16*)base + row * DM) + lane + 64 * j); v[j] = pg8::bflo(w.x, w.y); }
    }
}
__device__ __forceinline__ void ctx_reduce(f32x4 (&v)[4], int rc, const float* part, const float* pgate, float coef, bf16* xc_out, int lane) {
#pragma unroll
    for (int j = 0; j < 4; ++j) {
        f32x4 s = *((const f32x4*)(part + (size_t)rc * DM) + lane + 64 * j);
#pragma unroll
        for (int sl = 1; sl < 4; ++sl) s = s + *((const f32x4*)(part + ((size_t)sl * MCTX + rc) * DM) + lane + 64 * j);
        v[j] = v[j] + *((const f32x4*)pgate + lane + 64 * j) * coef * s;
        ((unsigned long long*)(xc_out + (size_t)rc * DM))[lane + 64 * j] = (unsigned long long)pk2(v[j][0], v[j][1]) | ((unsigned long long)pk2(v[j][2], v[j][3]) << 32);
    }
}
__device__ __forceinline__ void norm_phase(const void* xl, const void* xc, bool f32src, bool f32ctx, const float* g, const float* modl, int shift_q, int scale_q, bf16* H, int nrows,
                                           const float* part, const float* pgate, float coef, bf16* xc_out, int lane, int wave) {
    const int gw = blockIdx.x * NWAVES + wave, NGW = gridDim.x * NWAVES;
    f32x4 gv[4];
#pragma unroll
    for (int j = 0; j < 4; ++j) gv[j] = *((const f32x4*)g + lane + 64 * j);
    for (int r0 = gw; r0 < nrows; r0 += 2 * NGW) {
        const int r1 = r0 + NGW; const bool has1 = r1 < nrows; const int r1c = has1 ? r1 : r0;
        f32x4 v0[4], v1[4]; float s0 = 0.f, s1 = 0.f;
        row_load(v0, r0 < MLAT ? xl : xc, (size_t)(r0 < MLAT ? r0 : r0 - MLAT), r0 < MLAT ? f32src : f32ctx, lane);
        row_load(v1, r1c < MLAT ? xl : xc, (size_t)(r1c < MLAT ? r1c : r1c - MLAT), r1c < MLAT ? f32src : f32ctx, lane);
        if (part && r0 >= MLAT) ctx_reduce(v0, r0 - MLAT, part, pgate, coef, xc_out, lane);
        if (part && has1 && r1 >= MLAT) ctx_reduce(v1, r1 - MLAT, part, pgate, coef, xc_out, lane);
#pragma unroll
        for (int j = 0; j < 4; ++j) { s0 += (v0[j][0] * v0[j][0] + v0[j][1] * v0[j][1]) + (v0[j][2] * v0[j][2] + v0[j][3] * v0[j][3]); s1 += (v1[j][0] * v1[j][0] + v1[j][1] * v1[j][1]) + (v1[j][2] * v1[j][2] + v1[j][3] * v1[j][3]); }
        const float rstd0 = 1.f / sqrtf(wave_sum(s0) * (1.f / DM) + RMS_EPS), rstd1 = 1.f / sqrtf(wave_sum(s1) * (1.f / DM) + RMS_EPS);
        const float* mv0 = modl + (r0 < MLAT ? (r0 >> 12) : 8) * NMODC; const float* mv1 = modl + (r1c < MLAT ? (r1c >> 12) : 8) * NMODC;
        unsigned long long* o0 = (unsigned long long*)(H + (size_t)r0 * DM) + lane; unsigned long long* o1 = (unsigned long long*)(H + (size_t)r1c * DM) + lane;
#pragma unroll
        for (int j = 0; j < 4; ++j) {
            const f32x4 sh0 = *((const f32x4*)(mv0 + shift_q * DM) + lane + 64 * j), sc0 = *((const f32x4*)(mv0 + scale_q * DM) + lane + 64 * j);
            const f32x4 y0 = v0[j] * rstd0 * gv[j] * (sc0 + 1.f) + sh0;
            o0[64 * j] = (unsigned long long)pk2(y0[0], y0[1]) | ((unsigned long long)pk2(y0[2], y0[3]) << 32);
            if (has1) {
                const f32x4 sh1 = *((const f32x4*)(mv1 + shift_q * DM) + lane + 64 * j), sc1 = *((const f32x4*)(mv1 + scale_q * DM) + lane + 64 * j);
                const f32x4 y1 = v1[j] * rstd1 * gv[j] * (sc1 + 1.f) + sh1;
                o1[64 * j] = (unsigned long long)pk2(y1[0], y1[1]) | ((unsigned long long)pk2(y1[2], y1[3]) << 32);
            }
        }
    }
}
__device__ __forceinline__ void final_norm(const bf16* x, float* out, const float* g, int lane, int wave) {
    const int gw = blockIdx.x * NWAVES + wave, NGW = gridDim.x * NWAVES;
    f32x4 gv[4];
#pragma unroll
    for (int j = 0; j < 4; ++j) gv[j] = *((const f32x4*)g + lane + 64 * j);
    for (int r = gw; r < MLAT; r += NGW) {
        f32x4 v[4]; float s = 0.f;
        row_load(v, x, (size_t)r, false, lane);
#pragma unroll
        for (int j = 0; j < 4; ++j) s += (v[j][0] * v[j][0] + v[j][1] * v[j][1]) + (v[j][2] * v[j][2] + v[j][3] * v[j][3]);
        const float rstd = 1.f / sqrtf(wave_sum(s) * (1.f / DM) + RMS_EPS);
        f32x4* orow = (f32x4*)(out + (size_t)r * DM) + lane;
#pragma unroll
        for (int j = 0; j < 4; ++j) __builtin_nontemporal_store(v[j] * rstd * gv[j], orow + 64 * j);
    }
}

#define MFMA16(a, b, c) __builtin_amdgcn_mfma_f32_16x16x32_bf16((a), (b), (c), 0, 0, 0)
#define AINL __attribute__((always_inline))
template <int NQ> struct AQ { bf16x8 qf[NQ][2]; float m[NQ], l[NQ]; f32x4 o[NQ][4]; };
struct KF { bf16x8 ka[2], kb[2]; };
struct VF { bf16x8 v[4]; };
__device__ __forceinline__ void k_load(KF& d, const bf16* kpa, const bf16* kpb) {
    d.ka[0] = *(const bf16x8*)kpa; d.ka[1] = *(const bf16x8*)(kpa + 32); d.kb[0] = *(const bf16x8*)kpb; d.kb[1] = *(const bf16x8*)(kpb + 32);
}
__device__ __forceinline__ void v_load(VF& d, const bf16* va, const bf16* vb) {
#pragma unroll
    for (int nb = 0; nb < 4; ++nb) { const u32x2 x = *(const u32x2*)(va + (size_t)nb * 16 * MALL), y = *(const u32x2*)(vb + (size_t)nb * 16 * MALL);
        u32x4 vw; vw.x = x.x; vw.y = x.y; vw.z = y.x; vw.w = y.y; d.v[nb] = __builtin_bit_cast(bf16x8, vw); }
}
template <int NQ> __device__ __forceinline__ void aq_init(AQ<NQ>& A) {
#pragma unroll
    for (int q = 0; q < NQ; ++q) { A.m[q] = NEGB; A.l[q] = 0.f;
#pragma unroll
        for (int nb = 0; nb < 4; ++nb) A.o[q][nb] = (f32x4){0.f, 0.f, 0.f, 0.f}; }
}
template <int NQ, class G, class F> __device__ __forceinline__ void pair_compute(AQ<NQ>& A, const KF& c, const VF& cv, G&& act, F&& f) {
    bf16x8 pf[NQ];
#pragma unroll
    for (int q = 0; q < NQ; ++q) {
        if (!act(q)) continue;
        f32x4 sa = {0.f, 0.f, 0.f, 0.f}, sb = {0.f, 0.f, 0.f, 0.f};
        sa = MFMA16(c.ka[0], A.qf[q][0], sa); sa = MFMA16(c.ka[1], A.qf[q][1], sa);
        sb = MFMA16(c.kb[0], A.qf[q][0], sb); sb = MFMA16(c.kb[1], A.qf[q][1], sb);
        f(q, sa, sb);
        float mx = fmaxf(fmaxf(fmaxf(sa[0], sa[1]), fmaxf(sa[2], sa[3])), fmaxf(fmaxf(sb[0], sb[1]), fmaxf(sb[2], sb[3])));
        mx = fmaxf(mx, __shfl_xor(mx, 16)); mx = fmaxf(mx, __shfl_xor(mx, 32));
        const float mn = fmaxf(A.m[q], mx), sc = ex2(A.m[q] - mn);
        A.m[q] = mn;
#pragma unroll
        for (int nb = 0; nb < 4; ++nb) A.o[q][nb] = A.o[q][nb] * sc;
#pragma unroll
        for (int i = 0; i < 4; ++i) { sa[i] = ex2(sa[i] - mn); sb[i] = ex2(sb[i] - mn); }
        A.l[q] = A.l[q] * sc + ((sa[0] + sa[1]) + (sa[2] + sa[3])) + ((sb[0] + sb[1]) + (sb[2] + sb[3]));
        u32x4 pw; pw.x = pk2(sa[0], sa[1]); pw.y = pk2(sa[2], sa[3]); pw.z = pk2(sb[0], sb[1]); pw.w = pk2(sb[2], sb[3]);
        pf[q] = __builtin_bit_cast(bf16x8, pw);
    }
#pragma unroll
    for (int q = 0; q < NQ; ++q) {
        if (!act(q)) continue;
#pragma unroll
        for (int nb = 0; nb < 4; ++nb) A.o[q][nb] = MFMA16(cv.v[nb], pf[q], A.o[q][nb]);
    }
}
template <class LD, class ST> __device__ __forceinline__ void pingpong(int n, LD&& ld, ST&& st) {
    KF k0, k1;
    ld(k0, 0);
    int t = 0;
#pragma unroll 1
    for (; t + 1 < n; t += 2) {
        ld(k1, t + 1);
        st(k0, t);
        ld(k0, min(t + 2, n - 1));
        st(k1, t + 1);
    }
    if (t < n) st(k0, t);
}
template <int NQ> __device__ __forceinline__ void ctx_chunk(AQ<NQ>& A, const bf16* kp, int ldk, const bf16* vp) {
    pingpong(8,
        [&](KF& kf, int t) AINL { k_load(kf, kp + (size_t)(32 * t) * ldk, kp + (size_t)(32 * t + 16) * ldk); },
        [&](const KF& kf, int t) AINL { VF vf; v_load(vf, vp + 32 * t, vp + 32 * t + 16); pair_compute<NQ>(A, kf, vf, [](int) AINL { return true; }, [](int, f32x4&, f32x4&) AINL {}); });
}
__device__ __forceinline__ void attn_store1(const f32x4 (&o)[4], float l, bf16* yp  ) {
    l += __shfl_xor(l, 16); l += __shfl_xor(l, 32);
    const float inv = 1.f / l;
#pragma unroll
    for (int nb = 0; nb < 4; ++nb) { u32x2 w; w.x = pk2(o[nb][0] * inv, o[nb][1] * inv); w.y = pk2(o[nb][2] * inv, o[nb][3] * inv); *(u32x2*)(yp + 16 * nb) = w; }
}
template <int NQ> __device__ __forceinline__ void sink_fold(AQ<NQ>& A, const float* sink, int h0, int fq) {
#pragma unroll
    for (int q = 0; q < NQ; ++q) { const float sk = sink[h0 + q] * LOG2E, mn = fmaxf(A.m[q], sk), sc = ex2(A.m[q] - mn); A.l[q] *= sc;
#pragma unroll
        for (int nb = 0; nb < 4; ++nb) A.o[q][nb] = A.o[q][nb] * sc;
        if (fq == 0) A.l[q] += ex2(sk - mn); }
}

struct AttnBufs { const bf16 *QA, *KA, *QB, *KB, *VT; bf16 *YA, *YB; };

__device__ __forceinline__ void na_unit(const AttnBufs& T, const LAS float* btab, int b, int h, int j, int rp, int fr, int fq) {
    const int hoff = h * 64, r0 = 2 * rp;
    AQ<2> A; aq_init<2>(A);
#pragma unroll
    for (int q = 0; q < 2; ++q) { const bf16* qp = T.QA + (size_t)(b * SEQ + (r0 + q) * 64 + 16 * j + fr) * 384 + hoff + 8 * fq; A.qf[q][0] = *(const bf16x8*)qp; A.qf[q][1] = *(const bf16x8*)(qp + 32); }
    const int ka0 = min(max(r0 - 4, 0), 56), kb0 = min(max(r0 - 3, 0), 56), nrow = kb0 - ka0 + 8, c0 = min(max(16 * j - 8, 0), 32);
    const int c = 16 * j + fr, w0 = min(max(c - 8, 0), 48);
    int dxo[8];
#pragma unroll
    for (int e = 0; e < 8; ++e) { const int kc = c0 + 16 * (e >> 2) + 4 * fq + (e & 3); const bool in = (kc >= w0) && (kc < w0 + 16); dxo[e] = in ? min(max(kc - c + 15, 0), 30) : 31; }
    {
        const int tk0 = b * SEQ + ka0 * 64 + c0;
        const bf16* kp = T.KA + (size_t)(tk0 + fr) * 384 + hoff + 8 * fq;
        const bf16* vp = T.VT + (size_t)(hoff + fr) * MALL + tk0 + 4 * fq;
        const LAS float* bh = btab + h * (15 * 32);
        pingpong(nrow,
            [&](KF& kf, int t) AINL { k_load(kf, kp + (size_t)(t * 64) * 384, kp + (size_t)(t * 64 + 16) * 384); },
            [&](const KF& kf, int t) AINL {
            VF vf; v_load(vf, vp + t * 64, vp + t * 64 + 16);
            const int ky = ka0 + t;
            pair_compute<2>(A, kf, vf,
                [&](int q) AINL { const int k0 = q ? kb0 : ka0; return (ky >= k0) && (ky < k0 + 8); },
                [&](int q, f32x4& sa, f32x4& sb) AINL {
                    const LAS float* rp_ = bh + (ky - (r0 + q) + 7) * 32;
#pragma unroll
                    for (int i = 0; i < 4; ++i) { sa[i] += rp_[dxo[i]]; sb[i] += rp_[dxo[4 + i]]; } }); });
    }
    ctx_chunk<2>(A, T.KA + (size_t)(MLAT + b * CTXL + fr) * 384 + hoff + 8 * fq, 384, T.VT + (size_t)(hoff + fr) * MALL + MLAT + b * CTXL + 4 * fq);
#pragma unroll
    for (int q = 0; q < 2; ++q) attn_store1(A.o[q], A.l[q], T.YA + (size_t)(b * SEQ + (r0 + q) * 64 + 16 * j + fr) * 384 + hoff + 4 * fq);
}
__device__ __forceinline__ void sw_unit(const AttnBufs& T, const float* sink, int b, int kvh, int qb, int fr, int fq) {
    const int q0 = 16 * qb, tq0 = b * SEQ + q0, khoff = kvh * 64, h0 = 3 * kvh;
    AQ<3> A; aq_init<3>(A);
#pragma unroll
    for (int q = 0; q < 3; ++q) { const bf16* qp = T.QB + (size_t)(tq0 + fr) * 384 + (h0 + q) * 64 + 8 * fq; A.qf[q][0] = *(const bf16x8*)qp; A.qf[q][1] = *(const bf16x8*)(qp + 32); }
    {
        const int tq = q0 + fr;
        const bool edge = (q0 < 128) || (q0 + 160 > SEQ);
        const bf16* kbase = T.KB + (size_t)(b * SEQ) * 128 + khoff + 8 * fq;
        const bf16* vrow = T.VT + (size_t)(384 + khoff + fr) * MALL + b * SEQ;
#define SW_KLOAD(dst, t) do { const int ka_ = q0 - 128 + 32 * (t); \
            k_load(dst, kbase + (size_t)min(max(ka_ + fr, 0), SEQ - 1) * 128, kbase + (size_t)min(max(ka_ + 16 + fr, 0), SEQ - 1) * 128); } while (0)
#define SW_VLOAD(dst, t) do { const int ka_ = q0 - 128 + 32 * (t); \
            v_load(dst, vrow + min(max(ka_ + 4 * fq, 0), SEQ - 4), vrow + min(max(ka_ + 16 + 4 * fq, 0), SEQ - 4)); } while (0)
        pingpong(9,
            [&](KF& kf, int t) AINL { SW_KLOAD(kf, t); },
            [&](const KF& kf, int t) AINL {
            VF vf; SW_VLOAD(vf, t);
            const int kt0 = q0 - 128 + 32 * t;
            const bool need = edge || (t == 0) || (t == 8);
            pair_compute<3>(A, kf, vf, [](int) AINL { return true; }, [&](int, f32x4& sa, f32x4& sb) AINL {
                if (need) {
#pragma unroll
                    for (int i = 0; i < 4; ++i) {
                        { const int tk = kt0 + 4 * fq + i, d = tq - tk; const bool ok = (d <= 128) && (d >= -128) && (tk >= 0) && (tk < SEQ); sa[i] = ok ? sa[i] : NEGB; }
                        { const int tk = kt0 + 16 + 4 * fq + i, d = tq - tk; const bool ok = (d <= 128) && (d >= -128) && (tk >= 0) && (tk < SEQ); sb[i] = ok ? sb[i] : NEGB; }
                    } } }); });
#undef SW_KLOAD
#undef SW_VLOAD
    }
    ctx_chunk<3>(A, T.KB + (size_t)(MLAT + b * CTXL + fr) * 128 + khoff + 8 * fq, 128, T.VT + (size_t)(384 + khoff + fr) * MALL + MLAT + b * CTXL + 4 * fq);
    sink_fold<3>(A, sink, h0, fq);
#pragma unroll
    for (int q = 0; q < 3; ++q) attn_store1(A.o[q], A.l[q], T.YB + (size_t)(tq0 + fr) * 384 + (h0 + q) * 64 + 4 * fq);
}
__device__ __forceinline__ void ctxa_unit(const AttnBufs& T, int b, int h, int qb, int fr, int fq) {
    const int tq0 = MLAT + b * CTXL + 16 * qb, hoff = h * 64;
    AQ<1> A; aq_init<1>(A);
    { const bf16* qp = T.QA + (size_t)(tq0 + fr) * 384 + hoff + 8 * fq; A.qf[0][0] = *(const bf16x8*)qp; A.qf[0][1] = *(const bf16x8*)(qp + 32); }
    ctx_chunk<1>(A, T.KA + (size_t)(MLAT + b * CTXL + fr) * 384 + hoff + 8 * fq, 384, T.VT + (size_t)(hoff + fr) * MALL + MLAT + b * CTXL + 4 * fq);
    attn_store1(A.o[0], A.l[0], T.YA + (size_t)(tq0 + fr) * 384 + hoff + 4 * fq);
}
__device__ __forceinline__ void ctxb_unit(const AttnBufs& T, const float* sink, int b, int kvh, int qb, int fr, int fq) {
    const int tq0 = MLAT + b * CTXL + 16 * qb, khoff = kvh * 64, h0 = 3 * kvh;
    AQ<3> A; aq_init<3>(A);
#pragma unroll
    for (int q = 0; q < 3; ++q) { const bf16* qp = T.QB + (size_t)(tq0 + fr) * 384 + (h0 + q) * 64 + 8 * fq; A.qf[q][0] = *(const bf16x8*)qp; A.qf[q][1] = *(const bf16x8*)(qp + 32); }
    ctx_chunk<3>(A, T.KB + (size_t)(MLAT + b * CTXL + fr) * 128 + khoff + 8 * fq, 128, T.VT + (size_t)(384 + khoff + fr) * MALL + MLAT + b * CTXL + 4 * fq);
    sink_fold<3>(A, sink, h0, fq);
#pragma unroll
    for (int q = 0; q < 3; ++q) attn_store1(A.o[q], A.l[q], T.YB + (size_t)(tq0 + fr) * 384 + (h0 + q) * 64 + 4 * fq);
}
constexpr int LWL = 0, LBT = 64512, LK = 76800, SROW = 144, SBUF = 64 * SROW, LBU = LK + 6 * SBUF;
struct Stage { u32x4 k, v; };
__device__ __forceinline__ void stage_load(Stage& s, const bf16* kg, const bf16* vg) { s.k = *(const u32x4*)kg; s.v = *(const u32x4*)vg; }
__device__ __forceinline__ void stage_write(LAS unsigned char* buf, const Stage& s, int tid) { const int o = (tid >> 3) * SROW + (tid & 7) * 16; *(LAS u32x4*)(buf + o) = s.k; *(LAS u32x4*)(buf + SBUF + o) = s.v; }
__device__ __forceinline__ void lds_kf(KF& d, const LAS unsigned char* kb, int tokoff, int fr, int fq) {
    const LAS unsigned char* p = kb + (tokoff + fr) * SROW + fq * 16;
    d.ka[0] = *(const LAS bf16x8*)p; d.ka[1] = *(const LAS bf16x8*)(p + 64); d.kb[0] = *(const LAS bf16x8*)(p + 16 * SROW); d.kb[1] = *(const LAS bf16x8*)(p + 16 * SROW + 64);
}
__device__ __forceinline__ void lds_vf(VF& d, const LAS unsigned char* vb, int tokoff, int fr, int fq) {
#pragma unroll
    for (int nb = 0; nb < 4; ++nb) { const LAS unsigned char* p = vb + (fr + 16 * nb) * SROW + (tokoff + 4 * fq) * 2; const u32x2 x = *(const LAS u32x2*)p, y = *(const LAS u32x2*)(p + 32);
        u32x4 vw; vw.x = x.x; vw.y = x.y; vw.z = y.x; vw.w = y.y; d.v[nb] = __builtin_bit_cast(bf16x8, vw); }
}
template <int NQ, class F> __device__ __forceinline__ void set_step(AQ<NQ>& A, const int q, const KF& c, const VF& cv, F&& f) {
    f32x4 sa = {0.f, 0.f, 0.f, 0.f}, sb = {0.f, 0.f, 0.f, 0.f};
    sa = MFMA16(c.ka[0], A.qf[q][0], sa); sa = MFMA16(c.ka[1], A.qf[q][1], sa);
    sb = MFMA16(c.kb[0], A.qf[q][0], sb); sb = MFMA16(c.kb[1], A.qf[q][1], sb);
    f(sa, sb);
    float mx = fmaxf(fmaxf(fmaxf(sa[0], sa[1]), fmaxf(sa[2], sa[3])), fmaxf(fmaxf(sb[0], sb[1]), fmaxf(sb[2], sb[3])));
    mx = fmaxf(mx, __shfl_xor(mx, 16)); mx = fmaxf(mx, __shfl_xor(mx, 32));
    const float mn = fmaxf(A.m[q], mx), sc = ex2(A.m[q] - mn);
    A.m[q] = mn;
#pragma unroll
    for (int nb = 0; nb < 4; ++nb) A.o[q][nb] = A.o[q][nb] * sc;
#pragma unroll
    for (int i = 0; i < 4; ++i) { sa[i] = ex2(sa[i] - mn); sb[i] = ex2(sb[i] - mn); }
    A.l[q] = A.l[q] * sc + ((sa[0] + sa[1]) + (sa[2] + sa[3])) + ((sb[0] + sb[1]) + (sb[2] + sb[3]));
    u32x4 pw; pw.x = pk2(sa[0], sa[1]); pw.y = pk2(sa[2], sa[3]); pw.z = pk2(sb[0], sb[1]); pw.w = pk2(sb[2], sb[3]);
    const bf16x8 pf = __builtin_bit_cast(bf16x8, pw);
#pragma unroll
    for (int nb = 0; nb < 4; ++nb) A.o[q][nb] = MFMA16(cv.v[nb], pf, A.o[q][nb]);
}
template <class SRC, class CMP> __device__ __forceinline__ void chunk_pipeline(LAS unsigned char* lds, int n, int tid, SRC&& src, CMP&& cmp) {
    Stage sA, sB; const bf16* kg; const bf16* vg;
    { Stage s0; src(0, kg, vg); stage_load(s0, kg, vg);
      if (n > 1) { src(1, kg, vg); stage_load(sA, kg, vg); }
      if (n > 2) { src(2, kg, vg); stage_load(sB, kg, vg); }
      stage_write(lds + LK, s0, tid); }
    __syncthreads();
    int i = 0, bi = 0;
#pragma unroll 1
    for (;;) {
        { LAS unsigned char* cur = lds + LK + bi * 2 * SBUF; const int bn = bi == 2 ? 0 : bi + 1;
          cmp(i, cur, cur + SBUF);
          if (i + 1 < n) stage_write(lds + LK + bn * 2 * SBUF, sA, tid);
          if (i + 3 < n) { src(i + 3, kg, vg); stage_load(sA, kg, vg); }
          __syncthreads(); ++i; bi = bn; if (i >= n) break; }
        { LAS unsigned char* cur = lds + LK + bi * 2 * SBUF; const int bn = bi == 2 ? 0 : bi + 1;
          cmp(i, cur, cur + SBUF);
          if (i + 1 < n) stage_write(lds + LK + bn * 2 * SBUF, sB, tid);
          if (i + 3 < n) { src(i + 3, kg, vg); stage_load(sB, kg, vg); }
          __syncthreads(); ++i; bi = bn; if (i >= n) break; }
    }
}
__device__ __forceinline__ void sw_block(const AttnBufs& T, const float* sink, LAS unsigned char* lds, int b, int kvh, int qblk, int tid, int wave, int fr, int fq) {
    const int q0 = 128 * qblk, wq0 = q0 + 16 * wave, tq0 = b * SEQ + wq0, khoff = kvh * 64, h0 = 3 * kvh;
    AQ<3> A; aq_init<3>(A);
#pragma unroll
    for (int q = 0; q < 3; ++q) { const bf16* qp = T.QB + (size_t)(tq0 + fr) * 384 + (h0 + q) * 64 + 8 * fq; A.qf[q][0] = *(const bf16x8*)qp; A.qf[q][1] = *(const bf16x8*)(qp + 32); }
    const int c_lo = q0 < 128 ? 2 : 0, c_hi = q0 + 256 > SEQ ? 4 : 6, nl = c_hi - c_lo;
    const int srow = tid >> 3, sseg = (tid & 7) * 8;
    chunk_pipeline(lds, nl + 4, tid,
        [&](int i, const bf16*& kg, const bf16*& vg) AINL {
            const int t0 = i < nl ? b * SEQ + q0 - 128 + 64 * (c_lo + i) : MLAT + b * CTXL + 64 * (i - nl);
            kg = T.KB + (size_t)(t0 + srow) * 128 + khoff + sseg; vg = T.VT + (size_t)(384 + khoff + srow) * MALL + t0 + sseg; },
        [&](int i, const LAS unsigned char* kb, const LAS unsigned char* vb) AINL {
            const bool loc = i < nl; const int t0 = q0 - 128 + 64 * (c_lo + i);
#pragma unroll
            for (int p = 0; p < 2; ++p) {
                const int ps = t0 + 32 * p;
                if (loc && !((ps + 31 >= wq0 - 128) && (ps <= wq0 + 15 + 128))) continue;
                const bool need = loc && !((ps >= wq0 + 15 - 128) && (ps + 31 <= wq0 + 128));
                KF kf; VF vf; lds_kf(kf, kb, 32 * p, fr, fq); lds_vf(vf, vb, 32 * p, fr, fq);
#pragma unroll
                for (int q = 0; q < 3; ++q) set_step<3>(A, q, kf, vf, [&](f32x4& sa, f32x4& sb) AINL {
                    if (need) {
#pragma unroll
                        for (int e = 0; e < 4; ++e) { const int da = (wq0 + fr) - (ps + 4 * fq + e), db = da - 16; sa[e] = (da <= 128 && da >= -128) ? sa[e] : NEGB; sb[e] = (db <= 128 && db >= -128) ? sb[e] : NEGB; }
                    } });
            } });
    sink_fold<3>(A, sink, h0, fq);
#pragma unroll
    for (int q = 0; q < 3; ++q) attn_store1(A.o[q], A.l[q], T.YB + (size_t)(tq0 + fr) * 384 + (h0 + q) * 64 + 4 * fq);
}
__device__ __forceinline__ void na_block(const AttnBufs& T, const LAS float* btab, LAS unsigned char* lds, int b, int h, int g, int tid, int wave, int fr, int fq) {
    const int hoff = h * 64, r = 4 * g + (wave >> 1), jb = 2 * (wave & 1), tq0 = b * SEQ + r * 64 + 16 * jb;
    AQ<2> A; aq_init<2>(A);
    unsigned dxp[2][2];
    int c0s[2];
#pragma unroll
    for (int jj = 0; jj < 2; ++jj) {
        const int j = jb + jj;
        const bf16* qp = T.QA + (size_t)(tq0 + 16 * jj + fr) * 384 + hoff + 8 * fq; A.qf[jj][0] = *(const bf16x8*)qp; A.qf[jj][1] = *(const bf16x8*)(qp + 32);
        const int c = 16 * j + fr, w0 = min(max(c - 8, 0), 48), c0 = min(max(16 * j - 8, 0), 32);
        c0s[jj] = c0;
#pragma unroll
        for (int x = 0; x < 2; ++x) { unsigned w = 0;
#pragma unroll
            for (int e = 0; e < 4; ++e) { const int kc = c0 + 16 * x + 4 * fq + e; const bool in = (kc >= w0) && (kc < w0 + 16); const int dx = in ? min(max(kc - c + 15, 0), 30) : 31; w |= (unsigned)(4 * dx) << (8 * e); }
            dxp[jj][x] = w; }
    }
    const int kr0 = min(max(r - 4, 0), 56), ku0 = min(max(4 * g - 4, 0), 56), nl = min(max(4 * g - 1, 0), 56) + 8 - ku0;
    const int srow = tid >> 3, sseg = (tid & 7) * 8;
    const LAS unsigned char* bh = (const LAS unsigned char*)(btab + h * (15 * 32));
    chunk_pipeline(lds, nl + 4, tid,
        [&](int i, const bf16*& kg, const bf16*& vg) AINL {
            const int t0 = i < nl ? b * SEQ + (ku0 + i) * 64 : MLAT + b * CTXL + 64 * (i - nl);
            kg = T.KA + (size_t)(t0 + srow) * 384 + hoff + sseg; vg = T.VT + (size_t)(hoff + srow) * MALL + t0 + sseg; },
        [&](int i, const LAS unsigned char* kb, const LAS unsigned char* vb) AINL {
            if (i < nl) {
                const int ky = ku0 + i;
                if ((ky >= kr0) && (ky < kr0 + 8)) {
                    const LAS unsigned char* rp_ = bh + (ky - r + 7) * 128;
#pragma unroll
                    for (int jj = 0; jj < 2; ++jj) {
                        KF kf; VF vf; lds_kf(kf, kb, c0s[jj], fr, fq); lds_vf(vf, vb, c0s[jj], fr, fq);
                        set_step<2>(A, jj, kf, vf, [&](f32x4& sa, f32x4& sb) AINL {
#pragma unroll
                            for (int e = 0; e < 4; ++e) { sa[e] += *(const LAS float*)(rp_ + ((dxp[jj][0] >> (8 * e)) & 0xffu)); sb[e] += *(const LAS float*)(rp_ + ((dxp[jj][1] >> (8 * e)) & 0xffu)); } });
                    }
                }
            } else {
#pragma unroll
                for (int p = 0; p < 2; ++p) { KF kf; VF vf; lds_kf(kf, kb, 32 * p, fr, fq); lds_vf(vf, vb, 32 * p, fr, fq);
#pragma unroll
                    for (int jj = 0; jj < 2; ++jj) set_step<2>(A, jj, kf, vf, [](f32x4&, f32x4&) AINL {}); }
            } });
#pragma unroll
    for (int jj = 0; jj < 2; ++jj) attn_store1(A.o[jj], A.l[jj], T.YA + (size_t)(tq0 + 16 * jj + fr) * 384 + hoff + 4 * fq);
}

__device__ __forceinline__ void conv_unit(const bf16* HG, bf16* YC, const LAS float* wl, const float* dwb, const float* lng, const float* lnb, int tok0, int lo, int hi, int lane) {
    const f32x4 bias = *((const f32x4*)dwb + lane);
    f32x4 acc[16];
#pragma unroll
    for (int t = 0; t < 16; ++t) acc[t] = bias;
#pragma unroll 1
    for (int ig = 0; ig < 6; ++ig) {
        u32x2 hv[8];
#pragma unroll
        for (int k = 0; k < 8; ++k) { const int r = tok0 - 15 + 8 * ig + k; hv[k] = (u32x2){0u, 0u}; if (r >= lo && r < hi) hv[k] = *(const u32x2*)(HG + (size_t)r * 256 + 4 * lane); }
#pragma unroll
        for (int k = 0; k < 8; ++k) {
            const f32x4 h = pg8::bflo(hv[k].x, hv[k].y);
            const LAS float* wp = wl + (8 * ig + k + 15) * 256 + 4 * lane;
#pragma unroll
            for (int t = 0; t < 16; ++t) acc[t] = acc[t] + h * *(const LAS f32x4*)(wp - t * 256);
        }
    }
    const f32x4 g = *((const f32x4*)lng + lane), be = *((const f32x4*)lnb + lane);
#pragma unroll
    for (int t = 0; t < 16; ++t) {
        const f32x4 v = acc[t];
        const float mu = wave_sum((v[0] + v[1]) + (v[2] + v[3])) * (1.f / 256.f);
        const f32x4 d = v - mu;
        const float var = wave_sum((d[0] * d[0] + d[1] * d[1]) + (d[2] * d[2] + d[3] * d[3])) * (1.f / 256.f);
        const float rstd = 1.f / sqrtf(var + RMS_EPS);
        const f32x4 y = d * rstd * g + be;
        u32x2 o; o.x = pk2(silu_f(y[0]), silu_f(y[1])); o.y = pk2(silu_f(y[2]), silu_f(y[3]));
        *(u32x2*)(YC + (size_t)(tok0 + t) * 256 + 4 * lane) = o;
    }
}

template <int rep> __device__ __forceinline__ void mixer_phase(KArgs pa, LAS unsigned char* lds, int l, int tid, int lane, int wave) {
    unsigned char* R = pa->ws + WS_R;
    AttnBufs T; T.QA = (const bf16*)(R + R_QA); T.KA = (const bf16*)(R + R_KA); T.QB = (const bf16*)(R + R_QB); T.KB = (const bf16*)(R + R_KB); T.VT = (const bf16*)(R + R_VT);
    T.YA = (bf16*)(R + R_YA); T.YB = (bf16*)(R + R_YB);
    const bf16* HG = (const bf16*)(R + R_HG); bf16* YC = (bf16*)(R + R_YC);
    LAS float* wl = (LAS float*)lds;
    for (int i = tid; i < 63 * 256; i += NTHR) { const int w = (i >> 8) - 15; wl[i] = (w >= 0 && w < 31) ? pa->in[15][l * 31 * 256 + w * 256 + (i & 255)] : 0.f; }
    LAS float* btab = (LAS float*)(lds + LBT);
    for (int i = tid; i < 6 * 15 * 32; i += NTHR) { const int dx = i & 31, hd = i >> 5; btab[i] = dx < 31 ? pa->in[13][l * (6 * 15 * 31) + hd * 31 + dx] * LOG2E : NEGB; }
    __syncthreads();
    const float* sink = pa->in[14] + l * 6;
    const float* dwb = pa->in[16] + l * 256; const float* lng = pa->in[17] + l * 256; const float* lnb = pa->in[18] + l * 256;
    {
        unsigned* ctrb = (unsigned*)(pa->ws + WS_CTR) + 64 * (32 + 2 * rep + l);
        volatile LAS int* bu = (volatile LAS int*)(lds + LBU);
        constexpr int BU_NA = NB * 6 * 16, BU_SW = NB * 2 * 32;
        for (;;) {
            if (tid == 0) *bu = (int)__hip_atomic_fetch_add(ctrb, 1u, __ATOMIC_RELAXED, __HIP_MEMORY_SCOPE_AGENT);
            __syncthreads();
            const int u = __builtin_amdgcn_readfirstlane(*bu);
            __syncthreads();
            if (u >= BU_NA + BU_SW) break;
            int fr = lane & 15, fq = lane >> 4; asm volatile("" : "+v"(fr), "+v"(fq));
            if (u < BU_NA) { const int g = u & 15, bh_ = u >> 4;
#ifndef NO_NAB
 na_block(T, btab, lds, bh_ / 6, bh_ % 6, g, tid, wave, fr, fq);
#endif
 }
            else { const int v = u - BU_NA, qblk = v & 31, bk = v >> 5;
#ifndef NO_SWB
 sw_block(T, sink, lds, bk >> 1, bk & 1, qblk, tid, wave, fr, fq);
#endif
 }
        }
    }
    constexpr int B_CVL = SEQ / 16, B_CXA = 6 * 16, B_CXB = 2 * 16, B_CVC = CTXL / 16;
    const int total = B_CVL + (l == 0 ? B_CXA + B_CXB + B_CVC : 0);
    unsigned* ctr0 = (unsigned*)(pa->ws + WS_CTR) + 64 * 8 * (2 * rep + l);
    const int x0 = (int)((unsigned)__builtin_amdgcn_s_getreg((3 << 11) | 20) & 7u);
    for (int xi = 0; xi < 8; ++xi) {
        const int b = (x0 + xi) & 7;
        unsigned* ctr = ctr0 + 64 * b;
        for (;;) {
            int u = 0; if (lane == 0) u = (int)__hip_atomic_fetch_add(ctr, 1u, __ATOMIC_RELAXED, __HIP_MEMORY_SCOPE_AGENT);
            u = __builtin_amdgcn_readfirstlane(u);
            if (u >= total) break;
            int r = u;
            int fr = lane & 15, fq = lane >> 4; asm volatile("" : "+v"(fr), "+v"(fq));
            if (r < B_CVL) { const int tok0 = b * SEQ + 16 * r; conv_unit(HG, YC, wl, dwb, lng, lnb, tok0, b * SEQ, b * SEQ + SEQ, lane); continue; }
            r -= B_CVL;
            if (r < B_CXA) { const int qb = r & 15, h = r >> 4; ctxa_unit(T, b, h, qb, fr, fq); continue; }
            r -= B_CXA;
            if (r < B_CXB) { const int qb = r & 15, kvh = r >> 4; ctxb_unit(T, sink, b, kvh, qb, fr, fq); continue; }
            r -= B_CXB;
            { const int lo = MLAT + b * CTXL; conv_unit(HG, YC, wl, dwb, lng, lnb, lo + 16 * r, lo, lo + CTXL, lane); }
        }
    }
    __syncthreads();
}

#define RLX_AGENT __ATOMIC_RELAXED, __HIP_MEMORY_SCOPE_AGENT
#define XB_TMO      128
#define XB_XCNT(j)  (256  + 64 * (j))
#define XB_XSUB(j)  (1280 + 64 * (j))
#define XB_XGEN(j)  (2304 + 64 * (j))
#define XB_TOP      3328
#define XB_TOPGEN   3392
#define XCD_BAR_WORDS 3456
#define XB_SPIN_CAP (1u << 18)

__device__ __forceinline__ unsigned xb_ld(unsigned* p)              { return __hip_atomic_load(p, __ATOMIC_RELAXED, __HIP_MEMORY_SCOPE_AGENT); }
__device__ __forceinline__ unsigned xb_add(unsigned* p, unsigned v) { return __hip_atomic_fetch_add(p, v, __ATOMIC_RELAXED, __HIP_MEMORY_SCOPE_AGENT); }
__device__ __forceinline__ unsigned xb_xcc_id() { return (unsigned)__builtin_amdgcn_s_getreg((3 << 11) | 20) & 0xFu; }
#define XB_SPIN(cond, bar) do { unsigned _sp = 0; while (cond) { __builtin_amdgcn_s_sleep(1); \
    if ((++_sp & 255u) == 0u) { if (xb_ld(&(bar)[XB_TMO])) break; if (_sp > XB_SPIN_CAP) { atomicAdd(&(bar)[XB_TMO], 1u); break; } } } } while (0)

struct XcdBarrier {
    unsigned* bar; unsigned x;
    volatile LAS unsigned* st;
};

__device__ __forceinline__ XcdBarrier xcd_barrier_post(unsigned* bar, volatile LAS unsigned* st) {
    XcdBarrier b; b.bar = bar; b.x = xb_xcc_id(); b.st = st;
    if (threadIdx.x == 0) (void)xb_add(&bar[XB_XCNT(b.x)], 1u);
    return b;
}
__device__ __forceinline__ void xcd_barrier_complete(unsigned* bar, unsigned x, unsigned& nloc, unsigned& nx) {
    const unsigned G = gridDim.x * gridDim.y * gridDim.z;
    unsigned sum, cnt, mine, sp = 0u;
    for (;;) {
        sum = 0u; cnt = 0u; mine = 0u;
#pragma unroll
        for (unsigned j = 0; j < 16; ++j) { const unsigned c = xb_ld(&bar[XB_XCNT(j)]); sum += c; cnt += (c > 0u) ? 1u : 0u; mine = (j == x) ? c : mine; }
        if (sum == G) break;
        __builtin_amdgcn_s_sleep(1);
        if ((++sp & 255u) == 0u) { if (xb_ld(&bar[XB_TMO])) break; if (sp > XB_SPIN_CAP) { atomicAdd(&bar[XB_TMO], 1u); break; } }
    }
    nloc = mine > 0u ? mine : 1u; nx = cnt > 0u ? cnt : 1u;
}

__device__ __forceinline__ void xcd_barrier(const XcdBarrier& b) {
    asm volatile("s_waitcnt vmcnt(0)" ::: "memory");
    __syncthreads();
    if (threadIdx.x == 0) {
        unsigned* bar = b.bar;
        __builtin_amdgcn_s_waitcnt(0);
        unsigned nloc = b.st[0], nx = b.st[1];
        if (nloc == 0u) { xcd_barrier_complete(bar, b.x, nloc, nx); b.st[0] = nloc; b.st[1] = nx; }
        const unsigned old = xb_add(&bar[XB_XSUB(b.x)], 1u);
        const unsigned gen = old / nloc;
        if (old + 1u == (gen + 1u) * nloc) {
            __builtin_amdgcn_fence(__ATOMIC_RELEASE, "agent");
            asm volatile("s_waitcnt vmcnt(0)" ::: "memory");
            const unsigned og = xb_add(&bar[XB_TOP], 1u);
            const unsigned tg = og / nx;
            if (og + 1u == (tg + 1u) * nx) xb_add(&bar[XB_TOPGEN], 1u);
            else XB_SPIN(xb_ld(&bar[XB_TOPGEN]) == tg, bar);
            __builtin_amdgcn_fence(__ATOMIC_ACQUIRE, "agent");
            xb_add(&bar[XB_XGEN(b.x)], 1u);
            asm volatile("s_waitcnt vmcnt(0)" ::: "memory");
        } else {
            XB_SPIN(xb_ld(&bar[XB_XGEN(b.x)]) == gen, bar);
            __builtin_amdgcn_fence(__ATOMIC_ACQUIRE, "agent");
            asm volatile("s_waitcnt vmcnt(0)" ::: "memory");
        }
    }
    __syncthreads();
}

#ifdef NO_GEMM
#define GEMM_PHASE(EPI, g, S, E) do { (void)g; (void)S; (void)E; } while (0)
#else
#define GEMM_PHASE(EPI, g, S, E) pg8::gemm_phase<EPI, pg8::StaticOrder, true, true>(ldsp, g, S, E)
#endif
#define CTX_SPLITK(WDN) do { _Pragma("unroll 1") for (int sl = 0; sl < 4; ++sl) { const int kt0 = sl == 0 ? 0 : (sl == 1 ? 12 : (sl == 2 ? 24 : 34)), ntk = sl < 2 ? 12 : 10; \
        pg8::Gemm g2{(const bf16*)R + (size_t)MLAT * DFF + kt0 * 64, (WDN) + kt0 * 64, MCTX, DM, DFF, ntk * 64}; \
        pg8::StaticOrder S2; S2.init(MCTX, DM, G, (bx >= 32 * sl && bx < 32 * sl + 32) ? bx - 32 * sl : (1 << 28)); \
        pg8::EpiF32 E2{(float*)(ws + WS_P) + (size_t)sl * MCTX * DM, DM}; GEMM_PHASE(pg8::EpiF32, g2, S2, E2); } } while (0)

__global__ void __launch_bounds__(NTHR, 2) mk_fwd(Args a_unused) {
    extern __shared__ __attribute__((aligned(16))) unsigned char lds_raw[];
    LAS unsigned char* ldsp = (LAS unsigned char*)lds_raw;
    cg::grid_group grid = cg::this_grid();
#define IN(k) (pa->ph_lo <= (k) && (k) < pa->ph_hi)
#define SEAM(k) do { KArgs pa = kargs(); if (IN(k) && IN((k) + 1)) { XcdBarrier b_; b_.bar = (unsigned*)(pa->ws + WS_BAR); b_.x = xb_xcc_id(); b_.st = (volatile LAS unsigned*)(ldsp + LDS_ST); xcd_barrier(b_); } } while (0)
#define PH_BEGIN(k) { KArgs pa = kargs(); if (IN(k)) { unsigned char* ws = pa->ws; const int G = gridDim.x, bx = blockIdx.x; \
        int tid_l = threadIdx.x; asm volatile("" : "+v"(tid_l)); const int tid = tid_l, lane = tid & 63, wave = __builtin_amdgcn_readfirstlane(tid >> 6); (void)lane; (void)wave; \
        const bf16* W = (const bf16*)(ws + WS_W) + (size_t)l * WL_ELEMS; const float* modl = (const float*)(ws + WS_MOD) + (size_t)l * 9 * NMODC; \
        bf16* X = (bf16*)(ws + WS_XB); bf16* XC = (bf16*)(ws + WS_XC); bf16* H = (bf16*)(ws + WS_H); unsigned char* R = ws + WS_R; bf16* P = (bf16*)(ws + WS_P); \
        const int MP = (l == 1) ? MLAT : MALL; (void)G; (void)bx; (void)W; (void)modl; (void)X; (void)XC; (void)H; (void)R; (void)P; (void)MP;
#define PH_END(k) } } SEAM(k);
#ifndef REPMASK
#define REPMASK 0
#endif
#define REPK(kind) for (int rep_ = 0; rep_ < 1 + ((REPMASK >> (kind)) & 1); ++rep_)

        if (threadIdx.x < 2) ((volatile LAS unsigned*)(ldsp + LDS_ST))[threadIdx.x] = 0u;
    __syncthreads();
    { const int l = 0; PH_BEGIN(0) REPK(0) { prologue(pa, ldsp, tid, lane, wave); __syncthreads(); } } }
      grid.sync();
      { KArgs pa = kargs(); (void)xcd_barrier_post((unsigned*)(pa->ws + WS_BAR), (volatile LAS unsigned*)(ldsp + LDS_ST)); } }
#pragma unroll 1
    for (int l = 0; l < 2; ++l) {
        const int pb = 1 + 11 * l;
        PH_BEGIN(pb + 0) norm_phase(l == 0 ? (const void*)pa->in[0] : (const void*)X, l == 0 ? (const void*)pa->in[2] : (const void*)XC, l == 0, l == 0, pa->in[6] + l * 3 * DM, modl, 0, 1, H, MALL,
                l == 1 ? (const float*)(ws + WS_P) : (const float*)nullptr, (const float*)(ws + WS_MOD) + 8 * NMODC + 8 * DM, 0.5f, XC, lane, wave); PH_END(pb + 0)
        PH_BEGIN(pb + 1) pg8::Gemm g{H, W + WO_GU1, MALL, 2 * DFF, DM}; pg8::StaticOrder S; S.init(MALL, 2 * DFF, G, bx); pg8::EpiSwiGLU E{(bf16*)R, DFF}; REPK(1) GEMM_PHASE(pg8::EpiSwiGLU, g, S, E); PH_END(pb + 1)
        PH_BEGIN(pb + 2) { pg8::Gemm g{(const bf16*)R, W + WO_DN1, MLAT, DM, DFF}; pg8::StaticOrder S; S.init(MLAT, DM, G, bx);
            pg8::EpiResid E{l == 0 ? (const void*)pa->in[0] : (const void*)X, l == 0 ? (const void*)pa->in[2] : (const void*)XC, l == 0 ? 1 : 0, X, XC, modl + 2 * DM, 0.5f}; GEMM_PHASE(pg8::EpiResid, g, S, E); }
            CTX_SPLITK(W + WO_DN1);
        PH_END(pb + 2)
        PH_BEGIN(pb + 3) REPK(3) norm_phase(X, l == 0 ? (const void*)pa->in[2] : (const void*)XC, false, l == 0, pa->in[6] + l * 3 * DM + DM, modl, 3, 4, H, MALL,
                (const float*)(ws + WS_P), modl + 8 * NMODC + 2 * DM, 0.5f, XC, lane, wave); PH_END(pb + 3)
        PH_BEGIN(pb + 4)
            { pg8::Gemm g{H, W + WO_IN, MALL, 1792, DM}; pg8::StaticOrder S; S.init(MALL, 1792, G, bx);
              pg8::EpiIn1 E{(bf16*)(R + R_QB), (bf16*)(R + R_KB), (bf16*)(R + R_QA), (bf16*)(R + R_KA), (bf16*)(R + R_HG), (const float*)(ws + WS_ROPE), SCL2}; GEMM_PHASE(pg8::EpiIn1, g, S, E); }
            { pg8::Gemm g{W + WO_IN + (size_t)1792 * DM, H, 512, MALL, DM}; pg8::StaticOrder S; S.init(512, MALL, G, G - 1 - bx); pg8::EpiBf16 E{(bf16*)(R + R_VT), MALL};   GEMM_PHASE(pg8::EpiBf16, g, S, E); }
        PH_END(pb + 4)
        #ifndef NO_MIX
        PH_BEGIN(pb + 5) mixer_phase<0>(pa, ldsp, l, tid, lane, wave);
        PH_END(pb + 5)
#endif
        PH_BEGIN(pb + 6)
            REPK(6)
#pragma unroll 1
            for (int br = 0; br < 3; ++br) {
                const bf16* Y = (const bf16*)(R + (br == 0 ? R_YA : (br == 1 ? R_YB : R_YC))); const int Kb = br == 2 ? 256 : 384;
                const bf16* Wb = W + (br == 0 ? WO_OA : (br == 1 ? WO_OB : WO_OC));
                { pg8::Gemm g{Y, Wb, MP, DM, Kb}; pg8::StaticOrder S; S.init(MP, DM, G, bx); pg8::EpiBf16 E{P, DM}; GEMM_PHASE(pg8::EpiBf16, g, S, E); }
                { pg8::Gemm g{H, W + WO_IN + (size_t)(2304 + 1024 * br) * DM, MP, DM, DM}; pg8::StaticOrder S; S.init(MP, DM, G, bx);
                  pg8::EpiGate E{P, (bf16*)R, pa->in[12] + l * 3072 + br * 1024, br}; GEMM_PHASE(pg8::EpiGate, g, S, E); }
            }
        PH_END(pb + 6)
        PH_BEGIN(pb + 7) pg8::Gemm g{P, W + WO_WO, MP, DM, DM}; pg8::StaticOrder S; S.init(MP, DM, G, bx); pg8::EpiResid E{X, XC, 0, X, XC, modl + 5 * DM, 1.0f}; GEMM_PHASE(pg8::EpiResid, g, S, E); PH_END(pb + 7)
        PH_BEGIN(pb + 8) norm_phase(X, XC, false, false, pa->in[6] + l * 3 * DM + 2 * DM, modl, 6, 7, H, MP, (const float*)nullptr, (const float*)nullptr, 0.f, XC, lane, wave); PH_END(pb + 8)
        PH_BEGIN(pb + 9) pg8::Gemm g{H, W + WO_GU2, MP, 2 * DFF, DM}; pg8::StaticOrder S; S.init(MP, 2 * DFF, G, bx); pg8::EpiSwiGLU E{(bf16*)R, DFF}; GEMM_PHASE(pg8::EpiSwiGLU, g, S, E); PH_END(pb + 9)
        PH_BEGIN(pb + 10) { pg8::Gemm g{(const bf16*)R, W + WO_DN2, MLAT, DM, DFF}; pg8::StaticOrder S; S.init(MLAT, DM, G, bx); pg8::EpiResid E{X, XC, 0, X, XC, modl + 8 * DM, 0.5f}; GEMM_PHASE(pg8::EpiResid, g, S, E); }
            if (l == 0) CTX_SPLITK(W + WO_DN2);
        PH_END(pb + 10)
    }
#ifdef PROBE_SYNCS
    for (int i_ = 0; i_ < 24; ++i_) grid.sync();
#endif
    { const int l = 0; PH_BEGIN(23) final_norm(X, pa->out, pa->in[23], lane, wave); } } }
#undef IN
#undef SEAM
}

#ifndef MK_MULTI
#define MK_MULTI 0
#endif
extern "C" void kernel_launch(void* const* d_in, const int* in_sizes, int n_in, void* d_out, int out_size, void* d_ws, size_t ws_size, hipStream_t stream) {
    static int grid = 0;
    if (grid == 0) {
        if (n_in != 24 || out_size != MLAT * DM || ws_size < WS_END) { fprintf(stderr, "kernel_launch: unexpected shapes (n_in %d out %d ws %zu)\n", n_in, out_size, ws_size); grid = -1; return; }
        int dev = 0, cus = 0, per_cu = 0;
        if (hipGetDevice(&dev) != hipSuccess || hipDeviceGetAttribute(&cus, hipDeviceAttributeMultiprocessorCount, dev) != hipSuccess) { grid = -1; return; }
        if (hipFuncSetAttribute((const void*)mk_fwd, hipFuncAttributeMaxDynamicSharedMemorySize, LDS_BYTES) != hipSuccess) { fprintf(stderr, "kernel_launch: hipFuncSetAttribute failed\n"); grid = -1; return; }
        if (hipOccupancyMaxActiveBlocksPerMultiprocessor(&per_cu, (const void*)mk_fwd, NTHR, LDS_BYTES) != hipSuccess || per_cu < 1) { fprintf(stderr, "kernel_launch: occupancy query says %d\n", per_cu); per_cu = 1; }
        (void)hipGetLastError();
        grid = cus * per_cu;
    }
    if (grid < 0) return;
    Args a{};
    for (int i = 0; i < 24; ++i) a.in[i] = (const float*)d_in[i];
    a.out = (float*)d_out; a.ws = (unsigned char*)d_ws;
#if MK_MULTI
    for (int p = 0; p < 24; ++p) { a.ph_lo = p; a.ph_hi = p + 1; hipLaunchKernelGGL(mk_fwd, dim3(grid), dim3(NTHR), LDS_BYTES, stream, a); }
#else
    a.ph_lo = 0; a.ph_hi = 24;
    void* args[] = {&a};
    hipError_t e = hipLaunchCooperativeKernel((const void*)mk_fwd, dim3(grid), dim3(NTHR), args, LDS_BYTES, stream);
    if (e != hipSuccess) fprintf(stderr, "cooperative launch failed: %s (grid %d)\n", hipGetErrorString(e), grid);
#endif
}
```
